# Optimizing an MI355X kernel written in HIP

```python
import jax, jax.numpy as jnp
from jax import lax
import numpy as np

D_MODEL = 1024
BATCH = 8
SEQ = 4096
DEPTH = 2

CHUNK = 64
SB_HEADS = 8
SB_HEAD_DIM = 64
SB_WIDTH = SB_HEADS * SB_HEAD_DIM
SB_BLOCK = 128
SG_GROUPS = 4
SG_GROUP_DIM = 128
SG_WIDTH = SG_GROUPS * SG_GROUP_DIM
SG_CHUNK = 128
POOL_WINDOWS = (2, 4, 8, 16)
POOL_GROUPS = len(POOL_WINDOWS)
POOL_GROUP_DIM = 128
POOL_WIDTH = POOL_GROUPS * POOL_GROUP_DIM
N_BRANCHES = 3
BRANCH_WIDTH = 512
D_FF = 2816
CONV_WIDTH = 3
EPS = 1e-6
IN_SIZES = (SB_WIDTH, SB_WIDTH, SB_WIDTH, SG_WIDTH, SG_WIDTH, POOL_WIDTH, N_BRANCHES * D_MODEL)
IN_WIDTH = sum(IN_SIZES)
IN_SPLITS = tuple(int(i) for i in np.cumsum(IN_SIZES)[:-1])

kernel_name = "hybrid_stickbreak_sgu_pool_block"


def rmsnorm(x, g):
    xf = x.astype(jnp.float32)
    y = xf * lax.rsqrt(jnp.mean(xf * xf, axis=-1, keepdims=True) + EPS)
    return (y * g.astype(jnp.float32)).astype(x.dtype)


def layernorm(x, g, b):
    xf = x.astype(jnp.float32)
    mu = jnp.mean(xf, axis=-1, keepdims=True)
    var = jnp.mean(jnp.square(xf - mu), axis=-1, keepdims=True)
    y = (xf - mu) * lax.rsqrt(var + EPS)
    return (y * g.astype(jnp.float32) + b.astype(jnp.float32)).astype(x.dtype)


def stick_breaking_attention(q, k, v):
    _, _, S, Dh = q.shape
    scale = Dh ** -0.5
    outs = []
    for blk in range(S // SB_BLOCK):
        q0 = blk * SB_BLOCK
        end = q0 + SB_BLOCK
        qb = q[:, :, q0:end].astype(jnp.float32)
        kb = k[:, :, :end].astype(jnp.float32)
        vb = v[:, :, :end]
        z = jnp.einsum('bhtd,bhsd->bhts', qb, kb) * scale
        t_idx = q0 + jnp.arange(SB_BLOCK)[:, None]
        s_idx = jnp.arange(end)[None, :]
        strict = s_idx < t_idx
        log_keep = jnp.where(strict, jax.nn.log_sigmoid(-z), 0.0)
        after = lax.cumsum(log_keep, axis=3, reverse=True) - log_keep
        w = jnp.where(strict, jnp.exp(jax.nn.log_sigmoid(z) + after), 0.0)
        outs.append(jnp.einsum('bhts,bhsd->bhtd', w.astype(vb.dtype), vb))
    return jnp.concatenate(outs, axis=2)


def spatial_gating(u, v, w_s, b_s, ln_g, ln_b):
    B, S, _ = u.shape
    u = jax.nn.gelu(u)
    v = layernorm(jax.nn.gelu(v), ln_g, ln_b)
    vc = v.reshape(B, S // SG_CHUNK, SG_CHUNK, SG_GROUPS, SG_GROUP_DIM)
    causal = jnp.tril(jnp.ones((SG_CHUNK, SG_CHUNK), dtype=bool))
    w = jnp.where(causal[None], w_s, 0.0).astype(vc.dtype)
    mixed = jnp.einsum('gts,bnsgc->bntgc', w, vc) + b_s.T[None, None, :, :, None]
    return u * mixed.reshape(B, S, SG_WIDTH)


def multiscale_pool(xp, w_pool, scale):
    B, S, _ = xp.shape
    xg = xp.astype(jnp.float32).reshape(B, S, POOL_GROUPS, POOL_GROUP_DIM)
    cs = jnp.cumsum(xg, axis=1)
    n_valid = jnp.arange(1, S + 1)
    outs = []
    for g, win in enumerate(POOL_WINDOWS):
        c = cs[:, :, g]
        lagged = jnp.pad(c, ((0, 0), (win, 0), (0, 0)))[:, :S]
        count = jnp.minimum(n_valid, win).astype(jnp.float32)[None, :, None]
        pooled = (c - lagged) / count - xg[:, :, g]
        outs.append(pooled @ w_pool[g].astype(jnp.float32))
    y = jnp.concatenate(outs, axis=-1) * scale.astype(jnp.float32)
    return y.astype(xp.dtype)


def causal_depthwise_conv(h, w, b):
    S = h.shape[1]
    hp = jnp.pad(h, ((0, 0), (CONV_WIDTH - 1, 0), (0, 0)))
    y = b
    for i in range(CONV_WIDTH):
        y = y + hp[:, i:i + S] * w[i]
    return y


def setup_inputs(seed: int = 0) -> dict:
    key = jax.random.key(seed)
    ks = jax.random.split(key, 24)
    f32 = jnp.float32
    nrm = lambda k, shape, s: jax.random.normal(k, shape, f32) * s
    gain = lambda k, shape: 1.0 + 0.05 * jax.random.normal(k, shape, f32)
    L = DEPTH
    return {
        "x": jax.random.normal(ks[0], (BATCH, SEQ, D_MODEL), f32),
        "norm_pre_mix": gain(ks[1], (L, D_MODEL)),
        "w_in": nrm(ks[2], (L, D_MODEL, IN_WIDTH), D_MODEL ** -0.5),
        "sg_ln_g": gain(ks[3], (L, SG_WIDTH)),
        "sg_ln_b": nrm(ks[4], (L, SG_WIDTH), 0.02),
        "sg_w": nrm(ks[5], (L, SG_GROUPS, SG_CHUNK, SG_CHUNK), 0.5 * SG_CHUNK ** -0.5),
        "sg_b": gain(ks[6], (L, SG_GROUPS, SG_CHUNK)),
        "pool_w": nrm(ks[7], (L, POOL_GROUPS, POOL_GROUP_DIM, POOL_GROUP_DIM), POOL_GROUP_DIM ** -0.5),
        "pool_scale": gain(ks[8], (L, POOL_WIDTH)),
        "w_branch": nrm(ks[9], (L, N_BRANCHES, BRANCH_WIDTH, D_MODEL), BRANCH_WIDTH ** -0.5),
        "w_out": nrm(ks[10], (L, D_MODEL, D_MODEL), D_MODEL ** -0.5),
        "norm_post_mix": gain(ks[11], (L, D_MODEL)),
        "norm_pre_ffn": gain(ks[12], (L, D_MODEL)),
        "w_up": nrm(ks[13], (L, D_MODEL, 2 * D_FF), D_MODEL ** -0.5),
        "conv_w": nrm(ks[14], (L, CONV_WIDTH, 2 * D_FF), CONV_WIDTH ** -0.5),
        "conv_b": nrm(ks[15], (L, 2 * D_FF), 0.02),
        "w_down": nrm(ks[16], (L, D_FF, D_MODEL), D_FF ** -0.5),
        "norm_post_ffn": gain(ks[17], (L, D_MODEL)),
    }


def reference(x, norm_pre_mix, w_in, sg_ln_g, sg_ln_b, sg_w, sg_b, pool_w, pool_scale,
              w_branch, w_out, norm_post_mix, norm_pre_ffn, w_up, conv_w, conv_b, w_down,
              norm_post_ffn):
    B, S, D = x.shape
    to_heads = lambda t: t.reshape(B, S, SB_HEADS, SB_HEAD_DIM).transpose(0, 2, 1, 3)
    for l in range(DEPTH):
        h = rmsnorm(x, norm_pre_mix[l])
        proj = h @ w_in[l]
        q, k, v, u_sg, v_sg, x_pool, gate_logits = jnp.split(proj, IN_SPLITS, axis=-1)
        a = stick_breaking_attention(to_heads(q), to_heads(k), to_heads(v))
        a = a.transpose(0, 2, 1, 3).reshape(B, S, SB_WIDTH)
        b = spatial_gating(u_sg, v_sg, sg_w[l], sg_b[l], sg_ln_g[l], sg_ln_b[l])
        c = multiscale_pool(x_pool, pool_w[l], pool_scale[l])
        gates = jax.nn.sigmoid(gate_logits.reshape(B, S, N_BRANCHES, D))
        merged = (gates[:, :, 0] * (a @ w_branch[l, 0])
                  + gates[:, :, 1] * (b @ w_branch[l, 1])
                  + gates[:, :, 2] * (c @ w_branch[l, 2]))
        x = x + rmsnorm(merged @ w_out[l], norm_post_mix[l])
        h = rmsnorm(x, norm_pre_ffn[l])
        up = causal_depthwise_conv(h @ w_up[l], conv_w[l], conv_b[l])
        gt, val = jnp.split(up, 2, axis=-1)
        f = (jax.nn.gelu(gt, approximate=True) * val) @ w_down[l]
        x = x + rmsnorm(f, norm_post_ffn[l])
    return x
```

```cpp
#include <hip/hip_runtime.h>
#include <hip/hip_cooperative_groups.h>
#include <cstdio>
#include <cstdint>
namespace cg = cooperative_groups;
namespace pg8 {
#define PG8_LAS __attribute__((address_space(3)))
typedef unsigned short bf16_t;
typedef short bf16x8 __attribute__((ext_vector_type(8)));
typedef float f32x4 __attribute__((ext_vector_type(4)));
typedef unsigned u32x4 __attribute__((ext_vector_type(4)));
__device__ __forceinline__ int fresh_tid() { int t = threadIdx.x; asm volatile("" : "+v"(t)); return t; }
template <class T> __device__ __forceinline__ T* fresh_ptr(T* p) { asm volatile("" : "+s"(p)); return p; }
constexpr int BM = 256, BK = 64, HALF = 128, HTB = HALF * BK * 2  , STAGE_BYTES = 8 * HTB, NXCD = 8, WGM = 8;

__host__ __device__ __forceinline__ int lds_byte(int r, int c) { const int st = (r >> 4) * 2 + (c >> 5), rr = r & 15, cc = c & 31, ob = rr * 64 + cc * 2; return st * 1024 + (ob ^ (((ob >> 9) & 1) << 5)); }
__host__ __device__ __forceinline__ void stage_rc(int b, int& R, int& C) { const int st = b / 1024, sb = b % 1024, swz = sb ^ (((sb >> 9) & 1) << 5); R = (st >> 1) * 16 + swz / 64; C = (st & 1) * 32 + (swz % 64) / 2; }
__host__ __device__ __forceinline__ int perm32(int rho) { const int n = rho >> 4, i = rho & 15; return 8 * (i >> 2) + 4 * n + (i & 3); }

struct Unit { int pm, pn; };
struct Gemm { const bf16_t* A; const bf16_t* Bt; int M, N, K, lda, ldb; };

struct StaticOrder {
    int nM, nN, nwg, G, c;
    __host__ __device__ void init(int M, int N, int G_, int c_) { nM = M / BM; nN = N / BM; nwg = nM * nN; G = G_; c = c_; }
    __host__ __device__ bool next(int i, Unit& u) const {
        const long L = (long)i * G + c; if (L >= nwg) return false;
        int wgid = (int)L; { const int q = nwg / NXCD, r = nwg % NXCD, xcd = wgid % NXCD, off = wgid / NXCD; wgid = (xcd < r ? xcd * (q + 1) : r * (q + 1) + (xcd - r) * q) + off; }
        const int nig = WGM * nN, gid = wgid / nig, fm = gid * WGM, gsz = (nM - fm) < WGM ? (nM - fm) : WGM;
        u.pm = fm + ((wgid % nig) % gsz); u.pn = (wgid % nig) / gsz; return true;
    }
    __device__ __forceinline__ void a_ready(const Unit&) const {}
    __device__ __forceinline__ void done(const Unit&) const {}
};

typedef float f32x2_t __attribute__((ext_vector_type(2))); typedef __bf16 bf16x2_t __attribute__((ext_vector_type(2)));
__device__ __forceinline__ unsigned cvt_pk_bf16(float lo, float hi) { f32x2_t v = {lo, hi}; bf16x2_t b = __builtin_convertvector(v, bf16x2_t); return __builtin_bit_cast(unsigned, b); }
__device__ __forceinline__ float bf_lo(unsigned w) { return __uint_as_float(w << 16); }
__device__ __forceinline__ float bf_hi(unsigned w) { return __uint_as_float(w & 0xffff0000u); }
__device__ __forceinline__ float gelu_tanh_f(float x) { const float t = x * (1.0f + 0.044715f * x * x); return x * __builtin_amdgcn_rcpf(1.0f + __builtin_amdgcn_exp2f(-2.3022082f * t)); }
__device__ __forceinline__ float sigmoid_f(float x) { return __builtin_amdgcn_rcpf(1.0f + __builtin_amdgcn_exp2f(-1.4426950409f * x)); }

struct EpiPlain {
    static constexpr bool PERM = true, AFTER_DRAIN = false;
    bf16_t* O; int ldc;
    __device__ __forceinline__ void operator()(const f32x4 (&acc)[2][2][4][2], const Unit& u, int wr, int wc, int fr, int fq) const {
        const int row0 = u.pm * BM + wr * 64 + fr, col0 = u.pn * BM + wc * 32 + 8 * fq;
#pragma unroll
        for (int ai = 0; ai < 2; ++ai)
#pragma unroll
            for (int m = 0; m < 4; ++m) { bf16_t* rowp = O + (size_t)(row0 + ai * HALF + m * 16) * ldc + col0;
#pragma unroll
                for (int bj = 0; bj < 2; ++bj) { const f32x4 v0 = acc[ai][bj][m][0], v1 = acc[ai][bj][m][1];
                    u32x4 w; w.x = cvt_pk_bf16(v0[0], v0[1]); w.y = cvt_pk_bf16(v0[2], v0[3]); w.z = cvt_pk_bf16(v1[0], v1[1]); w.w = cvt_pk_bf16(v1[2], v1[3]);
                    *(u32x4*)(rowp + bj * HALF) = w; } }
    }
};
struct EpiProj {
    static constexpr bool PERM = true, AFTER_DRAIN = false;
    bf16_t* O; int ldc; float qscale;
    __device__ __forceinline__ void operator()(const f32x4 (&acc)[2][2][4][2], const Unit& u, int wr, int wc, int fr, int fq) const {
        const int row0 = u.pm * BM + wr * 64 + fr, col0 = u.pn * BM + wc * 32 + 8 * fq;
        const int sec = u.pn >> 1; const int mode = (sec == 0) ? 1 : (sec == 3 || sec == 4) ? 2 : (sec >= 6) ? 3 : 0;
#pragma unroll
        for (int ai = 0; ai < 2; ++ai)
#pragma unroll
            for (int m = 0; m < 4; ++m) { bf16_t* rowp = O + (size_t)(row0 + ai * HALF + m * 16) * ldc + col0;
#pragma unroll
                for (int bj = 0; bj < 2; ++bj) { f32x4 v0 = acc[ai][bj][m][0], v1 = acc[ai][bj][m][1];
                    if (mode == 1) { v0 = v0 * qscale; v1 = v1 * qscale; }
                    else if (mode == 2) {
#pragma unroll
                        for (int e = 0; e < 4; ++e) { v0[e] = gelu_tanh_f(v0[e]); v1[e] = gelu_tanh_f(v1[e]); } }
                    else if (mode == 3) {
#pragma unroll
                        for (int e = 0; e < 4; ++e) { v0[e] = sigmoid_f(v0[e]); v1[e] = sigmoid_f(v1[e]); } }
                    u32x4 w; w.x = cvt_pk_bf16(v0[0], v0[1]); w.y = cvt_pk_bf16(v0[2], v0[3]); w.z = cvt_pk_bf16(v1[0], v1[1]); w.w = cvt_pk_bf16(v1[2], v1[3]);
                    *(u32x4*)(rowp + bj * HALF) = w; } }
    }
};
template <int FIRST> struct EpiMerge {
    static constexpr bool PERM = true, AFTER_DRAIN = false;
    bf16_t* Mg; int ldm; const bf16_t* G; int ldg;
    __device__ __forceinline__ void operator()(const f32x4 (&acc)[2][2][4][2], const Unit& u, int wr, int wc, int fr, int fq) const {
        const int row0 = u.pm * BM + wr * 64 + fr, col0 = u.pn * BM + wc * 32 + 8 * fq;
#pragma unroll
        for (int ai = 0; ai < 2; ++ai)
#pragma unroll
            for (int m = 0; m < 4; ++m) { const size_t row = (size_t)(row0 + ai * HALF + m * 16);
#pragma unroll
                for (int bj = 0; bj < 2; ++bj) { f32x4 v0 = acc[ai][bj][m][0], v1 = acc[ai][bj][m][1];
                    const u32x4 gw = *(const u32x4*)(G + row * ldg + col0 + bj * HALF);
                    v0[0] *= bf_lo(gw.x); v0[1] *= bf_hi(gw.x); v0[2] *= bf_lo(gw.y); v0[3] *= bf_hi(gw.y);
                    v1[0] *= bf_lo(gw.z); v1[1] *= bf_hi(gw.z); v1[2] *= bf_lo(gw.w); v1[3] *= bf_hi(gw.w);
                    bf16_t* mp = Mg + row * ldm + col0 + bj * HALF;
                    if (!FIRST) { const u32x4 ow = *(const u32x4*)mp;
                        v0[0] += bf_lo(ow.x); v0[1] += bf_hi(ow.x); v0[2] += bf_lo(ow.y); v0[3] += bf_hi(ow.y);
                        v1[0] += bf_lo(ow.z); v1[1] += bf_hi(ow.z); v1[2] += bf_lo(ow.w); v1[3] += bf_hi(ow.w); }
                    u32x4 w; w.x = cvt_pk_bf16(v0[0], v0[1]); w.y = cvt_pk_bf16(v0[2], v0[3]); w.z = cvt_pk_bf16(v1[0], v1[1]); w.w = cvt_pk_bf16(v1[2], v1[3]);
                    *(u32x4*)mp = w; } }
    }
};

template <class Epi, class Sched, bool ALIGN_EPI = false, bool SP2 = false>
__device__ __forceinline__ void gemm_phase(PG8_LAS unsigned char* lds, const Gemm g, const Sched& S, const Epi& E) {
    const int tid = fresh_tid(), wid = __builtin_amdgcn_readfirstlane(tid >> 6), lane = tid & 63, wr = wid >> 2, wc = wid & 3, fr = lane & 15, fq = lane >> 4;
    const int K = g.K, nt = K / BK;
    unsigned voffA[2], voffB[2];
#pragma unroll
    for (int i = 0; i < 2; ++i) { int R, C; stage_rc(tid * 16 + i * 8192, R, C); const int Rb = Epi::PERM ? ((R & ~31) + perm32(R & 31)) : R;
        voffA[i] = (unsigned)(R * g.lda + C) * 2u; voffB[i] = (unsigned)(Rb * g.ldb + C) * 2u; }
    const size_t kstep = (size_t)(BK * 2);
    const size_t hstepA = (size_t)HALF * g.lda * 2, hstepB = (size_t)HALF * g.ldb * 2;
    const size_t tstepA = 2 * hstepA, tstepB = 2 * hstepB;
    const unsigned ldsw = (unsigned)wid * 1024u;
    const int aoff = lds_byte(wr * 64 + fr, fq * 8), boff = lds_byte(wc * 32 + fr, fq * 8);
#define PG8_SA(b, h) (((b) * 2 + (h)) * HTB)
#define PG8_SB(b, h) ((4 + (b) * 2 + (h)) * HTB)
#define PG8_STAGE(bufoff, gbase, voff) do { _Pragma("unroll") for (int _i = 0; _i < 2; ++_i) \
        __builtin_amdgcn_global_load_lds((const unsigned*)((const char*)(gbase) + (voff)[_i]), (PG8_LAS unsigned*)(lds + (bufoff) + ldsw + _i * 8192), 16, 0, 0); } while (0)
#define PG8_LDA(dst, b, h) do { _Pragma("unroll") for (int m = 0; m < 4; ++m) _Pragma("unroll") for (int k = 0; k < 2; ++k) dst[m][k] = *(const PG8_LAS bf16x8*)(lds + PG8_SA(b, h) + aoff + m * 2048 + k * 1024); } while (0)
#define PG8_LDB(dst, b, h) do { _Pragma("unroll") for (int n = 0; n < 2; ++n) _Pragma("unroll") for (int k = 0; k < 2; ++k) dst[n][k] = *(const PG8_LAS bf16x8*)(lds + PG8_SB(b, h) + boff + n * 2048 + k * 1024); } while (0)
#define PG8_MMA(ai, bj, At, Bt) do { __builtin_amdgcn_s_setprio(1); _Pragma("unroll") for (int m = 0; m < 4; ++m) _Pragma("unroll") for (int n = 0; n < 2; ++n) _Pragma("unroll") for (int k = 0; k < 2; ++k) \
        acc[ai][bj][m][n] = __builtin_amdgcn_mfma_f32_16x16x32_bf16(Bt[n][k], At[m][k], acc[ai][bj][m][n], 0, 0, 0); __builtin_amdgcn_s_setprio(0); } while (0)
#define PG8_WAIT_V(n) asm volatile("s_waitcnt vmcnt(" #n ")" ::: "memory")
#define PG8_WAIT_L(n) asm volatile("s_waitcnt lgkmcnt(" #n ")" ::: "memory")
#define PG8_BAR __builtin_amdgcn_s_barrier()
#define PG8_SCHED __builtin_amdgcn_sched_barrier(0)
    Unit cur, nxt; int ui = 0;
    if (!S.next(0, cur)) return;
    f32x4 acc[2][2][4][2];
#pragma unroll
    for (int a = 0; a < 2; ++a)
#pragma unroll
        for (int b = 0; b < 2; ++b)
#pragma unroll
            for (int m = 0; m < 4; ++m)
#pragma unroll
                for (int n = 0; n < 2; ++n) acc[a][b][m][n] = (f32x4){0.f, 0.f, 0.f, 0.f};
    bf16x8 At[4][2], B0[2][2], B1[2][2];
    const char* cA = (const char*)g.A + (size_t)cur.pm * tstepA; const char* cB = (const char*)g.Bt + (size_t)cur.pn * tstepB;
    S.a_ready(cur);
    if constexpr (SP2) {
        PG8_STAGE(PG8_SB(0, 0), cB, voffB); PG8_STAGE(PG8_SB(0, 1), cB + hstepB, voffB); PG8_STAGE(PG8_SA(0, 0), cA, voffA); PG8_STAGE(PG8_SA(0, 1), cA + hstepA, voffA);
        if (wr == 1) PG8_BAR;
        PG8_WAIT_V(2); PG8_BAR;
        PG8_STAGE(PG8_SB(1, 0), cB + kstep, voffB); PG8_STAGE(PG8_SA(1, 0), cA + kstep, voffA); PG8_STAGE(PG8_SB(1, 1), cB + hstepB + kstep, voffB);
        PG8_WAIT_V(6); PG8_BAR;
    } else {
        PG8_STAGE(PG8_SB(0, 0), cB, voffB); PG8_STAGE(PG8_SA(0, 0), cA, voffA); PG8_STAGE(PG8_SB(0, 1), cB + hstepB, voffB); PG8_STAGE(PG8_SA(0, 1), cA + hstepA, voffA);
        if (wr == 1) PG8_BAR;
        PG8_WAIT_V(4); PG8_BAR;
        PG8_STAGE(PG8_SB(1, 0), cB + kstep, voffB); PG8_STAGE(PG8_SA(1, 0), cA + kstep, voffA); PG8_STAGE(PG8_SB(1, 1), cB + hstepB + kstep, voffB);
        PG8_WAIT_V(6); PG8_BAR;
    }
    for (;;) {
        const bool has_next = S.next(ui + 1, nxt);
        const char* nA = has_next ? (const char*)g.A + (size_t)nxt.pm * tstepA : cA; const char* nB = has_next ? (const char*)g.Bt + (size_t)nxt.pn * tstepB : cB;
        for (int t = 0; t < nt; t += 2) {
            const bool last = (t == nt - 2);
            const char* a1 = cA + (size_t)(t + 1) * kstep;
            const char* a2 = last ? nA : cA + (size_t)(t + 2) * kstep; const char* b2 = last ? nB : cB + (size_t)(t + 2) * kstep;
            const char* a3 = a2 + kstep; const char* b3 = b2 + kstep;
            if (last && has_next) S.a_ready(nxt);
            if constexpr (SP2) {
            PG8_LDB(B0, 0, 0); PG8_LDB(B1, 0, 1); PG8_SCHED; PG8_LDA(At, 0, 0); PG8_STAGE(PG8_SA(1, 1), a1 + hstepA, voffA);
            PG8_WAIT_V(8); PG8_WAIT_L(0); PG8_BAR; PG8_MMA(0, 0, At, B0); PG8_MMA(0, 1, At, B1); PG8_BAR; PG8_SCHED;
            PG8_LDA(At, 0, 1); PG8_STAGE(PG8_SB(0, 0), b2, voffB); PG8_STAGE(PG8_SB(0, 1), b2 + hstepB, voffB); PG8_STAGE(PG8_SA(0, 0), a2, voffA);
            PG8_WAIT_V(8); PG8_WAIT_L(0); PG8_BAR; PG8_MMA(1, 0, At, B0); PG8_MMA(1, 1, At, B1); PG8_BAR; PG8_SCHED;
            PG8_LDB(B0, 1, 0); PG8_LDB(B1, 1, 1); PG8_SCHED; PG8_LDA(At, 1, 0); PG8_STAGE(PG8_SA(0, 1), a2 + hstepA, voffA);
            PG8_WAIT_V(8); PG8_WAIT_L(0); PG8_BAR; PG8_MMA(0, 0, At, B0); PG8_MMA(0, 1, At, B1); PG8_BAR; PG8_SCHED;
            PG8_LDA(At, 1, 1); PG8_STAGE(PG8_SB(1, 0), b3, voffB); PG8_STAGE(PG8_SB(1, 1), b3 + hstepB, voffB); PG8_STAGE(PG8_SA(1, 0), a3, voffA);
            PG8_WAIT_V(8); PG8_WAIT_L(0); PG8_BAR; PG8_MMA(1, 0, At, B0); PG8_MMA(1, 1, At, B1); PG8_BAR; PG8_SCHED;
            } else {
            PG8_LDB(B0, 0, 0); PG8_SCHED; PG8_LDA(At, 0, 0); PG8_STAGE(PG8_SA(1, 1), a1 + hstepA, voffA);
            PG8_WAIT_L(8); PG8_BAR; PG8_WAIT_L(0); PG8_MMA(0, 0, At, B0); PG8_BAR; PG8_SCHED;
            PG8_LDB(B1, 0, 1); PG8_STAGE(PG8_SB(0, 0), b2, voffB);
            PG8_BAR; PG8_WAIT_L(0); PG8_MMA(0, 1, At, B1); PG8_BAR;
            PG8_LDA(At, 0, 1); PG8_STAGE(PG8_SA(0, 0), a2, voffA);
            PG8_BAR; PG8_WAIT_L(0); PG8_MMA(1, 0, At, B0); PG8_BAR; PG8_SCHED;
            PG8_STAGE(PG8_SB(0, 1), b2 + hstepB, voffB);
            PG8_WAIT_V(6); PG8_BAR; PG8_MMA(1, 1, At, B1); PG8_BAR;
            PG8_LDB(B0, 1, 0); PG8_SCHED; PG8_LDA(At, 1, 0); PG8_STAGE(PG8_SA(0, 1), a2 + hstepA, voffA);
            PG8_WAIT_L(8); PG8_BAR; PG8_WAIT_L(0); PG8_MMA(0, 0, At, B0); PG8_BAR; PG8_SCHED;
            PG8_LDB(B1, 1, 1); PG8_STAGE(PG8_SB(1, 0), b3, voffB);
            PG8_BAR; PG8_WAIT_L(0); PG8_MMA(0, 1, At, B1); PG8_BAR;
            PG8_LDA(At, 1, 1); PG8_STAGE(PG8_SA(1, 0), a3, voffA);
            PG8_BAR; PG8_WAIT_L(0); PG8_MMA(1, 0, At, B0); PG8_BAR; PG8_SCHED;
            PG8_STAGE(PG8_SB(1, 1), b3 + hstepB, voffB);
            PG8_WAIT_V(6); PG8_BAR; PG8_MMA(1, 1, At, B1); PG8_BAR;
            }
        }
        if constexpr (ALIGN_EPI) { if (wr == 0) PG8_BAR; }
        if constexpr (!Epi::AFTER_DRAIN) { E(acc, cur, wr, wc, fr, fq); S.done(cur); }
        if (!has_next) break;
#pragma unroll
        for (int a = 0; a < 2; ++a)
#pragma unroll
            for (int b = 0; b < 2; ++b)
#pragma unroll
                for (int m = 0; m < 4; ++m)
#pragma unroll
                    for (int n = 0; n < 2; ++n) acc[a][b][m][n] = (f32x4){0.f, 0.f, 0.f, 0.f};
        cur = nxt; cA = nA; cB = nB; ++ui;
        if constexpr (ALIGN_EPI) { if (wr == 1) PG8_BAR; }
    }
    PG8_WAIT_V(0);
    if constexpr (!ALIGN_EPI) { if (wr == 0) PG8_BAR; }
    PG8_BAR;
    if constexpr (Epi::AFTER_DRAIN) { E.fused(acc, cur, wr, wc, fr, fq, lds, wid, lane); S.done(cur); }
#undef PG8_SA
#undef PG8_SB
#undef PG8_STAGE
#undef PG8_LDA
#undef PG8_LDB
#undef PG8_MMA
#undef PG8_WAIT_V
#undef PG8_WAIT_L
#undef PG8_BAR
#undef PG8_SCHED
}
}
namespace mk {
using pg8::bf16_t; using pg8::bf16x8; using pg8::f32x4; using pg8::u32x4; using pg8::cvt_pk_bf16; using pg8::bf_lo; using pg8::bf_hi;
typedef float f32x16 __attribute__((ext_vector_type(16)));
typedef short s16x4 __attribute__((ext_vector_type(4)));
typedef unsigned u32x2 __attribute__((ext_vector_type(2)));
#define LAS __attribute__((address_space(3)))
#define MFMA32(a, b, c) __builtin_amdgcn_mfma_f32_32x32x16_bf16((a), (b), (c), 0, 0, 0)

constexpr int NB = 8, SEQ = 4096, DM = 1024, MTOK = NB * SEQ, NIN = 6144, DFF = 2816, NUP = 5632, MH = MTOK / 2, NLAYER = 2;
constexpr int C_Q = 0, C_K = 512, C_V = 1024, C_U = 1536, C_VS = 2048, C_XP = 2560, C_G = 3072;
constexpr float EPS = 1e-6f;
constexpr float QSCALE = 0.125f * 1.4426950408889634f;
constexpr float R_STOP = 160.0f;
constexpr size_t MiB = 1u << 20;
constexpr size_t WS_WIN = 1 * MiB, WS_WBR = 13 * MiB, WS_WOUT = 16 * MiB, WS_WUP = 18 * MiB, WS_WDN = 29 * MiB, WS_SGW = 35 * MiB, WS_PLW = 35 * MiB + 512 * 1024;
constexpr size_t WS_H = 36 * MiB, WS_P = 100 * MiB, WS_END = 484 * MiB;
constexpr size_t WS_UP = WS_P, WS_ACT = WS_P + 176 * MiB, WS_Y = WS_P + 264 * MiB;
constexpr int LDS_BYTES = 147456;

__device__ __forceinline__ int crow(int r, int hi) { return (r & 3) + 8 * (r >> 2) + 4 * hi; }
__device__ __forceinline__ float wave_sum(float v) {
#pragma unroll
    for (int o = 1; o < 64; o <<= 1) v += __shfl_xor(v, o);
    return v;
}
__device__ __forceinline__ void transpose_item(const float* W, int K, int N, bf16_t* WT, LAS float* scr, int item, int lane) {
    const int nblk = N / 32, kb = item / nblk, nb = item % nblk, k0 = 64 * kb, n0 = 32 * nb;
#pragma unroll 8
    for (int i = 0; i < 32; ++i) { const int kk = 2 * i + (lane >> 5); scr[kk * 33 + (lane & 31)] = W[(size_t)(k0 + kk) * N + n0 + (lane & 31)]; }
    asm volatile("s_waitcnt lgkmcnt(0)" ::: "memory");
    const int c = lane & 7;
#pragma unroll
    for (int j = 0; j < 4; ++j) { const int n = (lane >> 3) + 8 * j; const LAS float* s = scr + (8 * c) * 33 + n;
        u32x4 o; o.x = cvt_pk_bf16(s[0 * 33], s[1 * 33]); o.y = cvt_pk_bf16(s[2 * 33], s[3 * 33]); o.z = cvt_pk_bf16(s[4 * 33], s[5 * 33]); o.w = cvt_pk_bf16(s[6 * 33], s[7 * 33]);
        *(u32x4*)(WT + (size_t)(n0 + n) * K + k0 + 8 * c) = o; }
    asm volatile("s_waitcnt lgkmcnt(0)" ::: "memory");
}
struct Ptrs {
    const float *x, *norm_pre_mix, *w_in, *sg_ln_g, *sg_ln_b, *sg_w, *sg_b, *pool_w, *pool_scale, *w_branch, *w_out, *norm_post_mix, *norm_pre_ffn, *w_up, *conv_w, *conv_b, *w_down, *norm_post_ffn;
    float* out; unsigned char* ws;
};
__device__ __forceinline__ void convert_weights(const Ptrs& P, int l, LAS unsigned char* lds, int gw, int NGW, int lane, int gtid, int NGT) {
    LAS float* scr = (LAS float*)(lds + (pg8::fresh_tid() >> 6) * 16384);
    constexpr int I_IN = (DM / 64) * (NIN / 32), I_BR = (512 / 64) * (DM / 32), I_OUT = (DM / 64) * (DM / 32), I_UP = (DM / 64) * (NUP / 32), I_DN = (DFF / 64) * (DM / 32);
    constexpr int NITEMS = I_IN + 3 * I_BR + I_OUT + I_UP + I_DN;
    unsigned char* ws = P.ws;
    for (int it = gw; it < NITEMS; it += NGW) {
        int r = it;
        if (r < I_IN) { transpose_item(P.w_in + (size_t)l * DM * NIN, DM, NIN, (bf16_t*)(ws + WS_WIN), scr, r, lane); continue; } r -= I_IN;
        if (r < 3 * I_BR) { const int i = r / I_BR; transpose_item(P.w_branch + ((size_t)l * 3 + i) * 512 * DM, 512, DM, (bf16_t*)(ws + WS_WBR) + (size_t)i * DM * 512, scr, r % I_BR, lane); continue; } r -= 3 * I_BR;
        if (r < I_OUT) { transpose_item(P.w_out + (size_t)l * DM * DM, DM, DM, (bf16_t*)(ws + WS_WOUT), scr, r, lane); continue; } r -= I_OUT;
        if (r < I_UP) { transpose_item(P.w_up + (size_t)l * DM * NUP, DM, NUP, (bf16_t*)(ws + WS_WUP), scr, r, lane); continue; } r -= I_UP;
        transpose_item(P.w_down + (size_t)l * DFF * DM, DFF, DM, (bf16_t*)(ws + WS_WDN), scr, r, lane);
    }
    bf16_t* sgw = (bf16_t*)(ws + WS_SGW); bf16_t* plw = (bf16_t*)(ws + WS_PLW);
    const float* sw = P.sg_w + (size_t)l * 65536; const float* pw = P.pool_w + (size_t)l * 65536;
    for (int i = gtid; i < 65536; i += NGT) {
        const int t = (i >> 7) & 127, s = i & 127; const float v = (s <= t) ? sw[i] : 0.f; sgw[i] = (bf16_t)(cvt_pk_bf16(v, 0.f) & 0xffffu);
        const int g = i >> 14, cp = (i >> 7) & 127, c = i & 127; plw[i] = (bf16_t)(cvt_pk_bf16(pw[g * 16384 + c * 128 + cp], 0.f) & 0xffffu);
    }
}
__device__ __forceinline__ void norm_row(const float* xrow, const float* g, bf16_t* hrow, int lane) {
    f32x4 v[4]; float ss = 0.f;
#pragma unroll
    for (int j = 0; j < 4; ++j) { v[j] = *(const f32x4*)(xrow + 4 * lane + 256 * j); ss += (v[j].x * v[j].x + v[j].y * v[j].y) + (v[j].z * v[j].z + v[j].w * v[j].w); }
    const float rstd = rsqrtf(wave_sum(ss) * (1.f / DM) + EPS);
#pragma unroll
    for (int j = 0; j < 4; ++j) { const f32x4 gg = *(const f32x4*)(g + 4 * lane + 256 * j); const f32x4 o = v[j] * rstd * gg;
        u32x2 w; w.x = cvt_pk_bf16(o.x, o.y); w.y = cvt_pk_bf16(o.z, o.w); *(u32x2*)(hrow + 4 * lane + 256 * j) = w; }
}
__device__ __forceinline__ void resid_row(const float* xold, const bf16_t* yrow, const float* gpost, float* xnew, const float* gnext, bf16_t* hrow, int lane) {
    f32x4 y[4]; float ss = 0.f;
#pragma unroll
    for (int j = 0; j < 4; ++j) { const u32x2 w = *(const u32x2*)(yrow + 4 * lane + 256 * j); y[j] = (f32x4){bf_lo(w.x), bf_hi(w.x), bf_lo(w.y), bf_hi(w.y)};
        ss += (y[j].x * y[j].x + y[j].y * y[j].y) + (y[j].z * y[j].z + y[j].w * y[j].w); }
    const float rstd = rsqrtf(wave_sum(ss) * (1.f / DM) + EPS);
    float s2 = 0.f;
#pragma unroll
    for (int j = 0; j < 4; ++j) { const f32x4 gg = *(const f32x4*)(gpost + 4 * lane + 256 * j); const f32x4 xo = *(const f32x4*)(xold + 4 * lane + 256 * j);
        y[j] = xo + y[j] * rstd * gg; *(f32x4*)(xnew + 4 * lane + 256 * j) = y[j];
        s2 += (y[j].x * y[j].x + y[j].y * y[j].y) + (y[j].z * y[j].z + y[j].w * y[j].w); }
    if (gnext) {
        const float r2 = rsqrtf(wave_sum(s2) * (1.f / DM) + EPS);
#pragma unroll
        for (int j = 0; j < 4; ++j) { const f32x4 gg = *(const f32x4*)(gnext + 4 * lane + 256 * j); const f32x4 o = y[j] * r2 * gg;
            u32x2 w; w.x = cvt_pk_bf16(o.x, o.y); w.y = cvt_pk_bf16(o.z, o.w); *(u32x2*)(hrow + 4 * lane + 256 * j) = w; }
    }
}
__device__ __forceinline__ void attn_unit(LAS unsigned char* lds, bf16_t* Pj, int b, int h, int qb) {
    const int tid = pg8::fresh_tid(), lane = tid & 63, r32 = lane & 31, hi = lane >> 5, w = __builtin_amdgcn_readfirstlane(tid >> 6);
    LAS bf16_t* Ks = (LAS bf16_t*)lds;
    LAS bf16_t* Vt = (LAS bf16_t*)(lds + 9216);
    volatile LAS int* flags = (volatile LAS int*)(lds + 18432);
    const size_t rowbase = (size_t)b * SEQ;
    const int q0 = qb * 256, qw = q0 + 32 * w, myq = qw + r32;
    bf16x8 qr[4];
    { const bf16_t* Qp = Pj + (rowbase + qw + r32) * NIN + C_Q + h * 64 + hi * 8;
#pragma unroll
      for (int d0 = 0; d0 < 4; ++d0) qr[d0] = *(const bf16x8*)(Qp + d0 * 16); }
    f32x16 o0, o1;
#pragma unroll
    for (int r = 0; r < 16; ++r) { o0[r] = 0.f; o1[r] = 0.f; }
    float R = 0.f; bool done = false;
    if (tid < 8) flags[tid] = 0;
    for (int jt = qb * 4 + 3; jt >= 0; --jt) {
        __syncthreads();
        { int f = 0;
#pragma unroll
          for (int i = 0; i < 8; ++i) f += flags[i];
          if (f == 8) break; }
        const int kv0 = jt * 64;
        { const int row = tid >> 3, ch = tid & 7;
          const bf16_t* src = Pj + (rowbase + kv0 + row) * NIN + h * 64 + ch * 8;
          const u32x4 kk = *(const u32x4*)(src + C_K); const u32x4 vv = *(const u32x4*)(src + C_V);
          *(LAS u32x4*)(Ks + row * 72 + ch * 8) = kk;
          LAS bf16_t* vd = Vt + (ch * 8) * 72 + row;
          vd[0 * 72] = (bf16_t)(vv.x & 0xffffu); vd[1 * 72] = (bf16_t)(vv.x >> 16); vd[2 * 72] = (bf16_t)(vv.y & 0xffffu); vd[3 * 72] = (bf16_t)(vv.y >> 16);
          vd[4 * 72] = (bf16_t)(vv.z & 0xffffu); vd[5 * 72] = (bf16_t)(vv.z >> 16); vd[6 * 72] = (bf16_t)(vv.w & 0xffffu); vd[7 * 72] = (bf16_t)(vv.w >> 16); }
        __syncthreads();
        if (!done && kv0 < qw + 32) {
            const bool need_mask = (kv0 + 64 > qw);
#pragma unroll
            for (int sub = 1; sub >= 0; --sub) {
                f32x16 p;
#pragma unroll
                for (int r = 0; r < 16; ++r) p[r] = 0.f;
#pragma unroll
                for (int d0 = 0; d0 < 4; ++d0) { const bf16x8 kf = *(const LAS bf16x8*)(Ks + (32 * sub + r32) * 72 + d0 * 16 + hi * 8); p = MFMA32(kf, qr[d0], p); }
                float c[16];
#pragma unroll
                for (int r = 0; r < 16; ++r) { const float zl = p[r]; const float e = __builtin_amdgcn_exp2f(-__builtin_fabsf(zl));
                    float sp = __builtin_fmaxf(zl, 0.f) + __builtin_amdgcn_logf(1.0f + e);
                    if (need_mask) { const int kv = kv0 + 32 * sub + crow(r, hi); if (kv >= myq) { sp = 0.f; p[r] = -1.0e30f; } }
                    c[r] = sp; }
                float U[4], sel[4];
#pragma unroll
                for (int g = 0; g < 4; ++g) { c[4 * g + 2] += c[4 * g + 3]; c[4 * g + 1] += c[4 * g + 2]; c[4 * g] += c[4 * g + 1];
                    const unsigned tu = __float_as_uint(c[4 * g]); auto rr = __builtin_amdgcn_permlane32_swap(tu, tu, false, false);
                    const float tlo = __uint_as_float(rr[0]), thi = __uint_as_float(rr[1]); U[g] = tlo + thi; sel[g] = hi ? 0.f : thi; }
                const float A2 = U[3], A1 = A2 + U[2], A0 = A1 + U[1];
                const float off[4] = {R + A0 + sel[0], R + A1 + sel[1], R + A2 + sel[2], R + sel[3]};
                R = R + (A0 + U[0]);
#pragma unroll
                for (int r = 0; r < 16; ++r) p[r] = __builtin_amdgcn_exp2f(p[r] - (c[r] + off[r >> 2]));
                u32x4 pw0, pw1;
                pw0.x = cvt_pk_bf16(p[0], p[1]); pw0.y = cvt_pk_bf16(p[2], p[3]); pw0.z = cvt_pk_bf16(p[4], p[5]); pw0.w = cvt_pk_bf16(p[6], p[7]);
                pw1.x = cvt_pk_bf16(p[8], p[9]); pw1.y = cvt_pk_bf16(p[10], p[11]); pw1.z = cvt_pk_bf16(p[12], p[13]); pw1.w = cvt_pk_bf16(p[14], p[15]);
                const bf16x8 pa0 = __builtin_bit_cast(bf16x8, pw0), pa1 = __builtin_bit_cast(bf16x8, pw1);
#pragma unroll
                for (int s = 0; s < 2; ++s) {
#pragma unroll
                    for (int db = 0; db < 2; ++db) { const LAS bf16_t* vp = Vt + (32 * db + r32) * 72 + 32 * sub + 16 * s + 4 * hi;
                        const s16x4 lo4 = *(const LAS s16x4*)vp, hi4 = *(const LAS s16x4*)(vp + 8);
                        const bf16x8 vf = (bf16x8){lo4[0], lo4[1], lo4[2], lo4[3], hi4[0], hi4[1], hi4[2], hi4[3]};
                        if (db == 0) o0 = MFMA32(s == 0 ? pa0 : pa1, vf, o0); else o1 = MFMA32(s == 0 ? pa0 : pa1, vf, o1); } }
            }
            float rm = R;
#pragma unroll
            for (int o = 1; o < 32; o <<= 1) rm = __builtin_fminf(rm, __shfl_xor(rm, o));
            if (rm > R_STOP) { done = true; if (lane == 0) flags[w] = 1; }
        }
    }
    { bf16_t* Op = Pj + (rowbase + qw) * NIN + C_Q + h * 64 + r32;
#pragma unroll
      for (int r = 0; r < 16; ++r) { bf16_t* rp = Op + (size_t)crow(r, hi) * NIN; rp[0] = (bf16_t)(cvt_pk_bf16(o0[r], 0.f) & 0xffffu); rp[32] = (bf16_t)(cvt_pk_bf16(o1[r], 0.f) & 0xffffu); } }
    __syncthreads();
}
__device__ __forceinline__ void sgp_unit(LAS unsigned char* lds, const Ptrs& P, int l, bf16_t* Pj, int b, int ck) {
    const int tid = pg8::fresh_tid(), lane = tid & 63, r32 = lane & 31, hi = lane >> 5, w = __builtin_amdgcn_readfirstlane(tid >> 6);
    LAS float* stat = (LAS float*)lds;
    LAS bf16_t* T = (LAS bf16_t*)(lds + 1024);
    const size_t rowbase = (size_t)b * SEQ + (size_t)ck * 128;
    const bf16_t* sgw = (const bf16_t*)(P.ws + WS_SGW); const bf16_t* plw = (const bf16_t*)(P.ws + WS_PLW);
    for (int i = 0; i < 16; ++i) { const int t = 16 * w + i; const u32x4 v = *(const u32x4*)(Pj + (rowbase + t) * NIN + C_VS + 8 * lane);
        const float a0 = bf_lo(v.x), a1 = bf_hi(v.x), a2 = bf_lo(v.y), a3 = bf_hi(v.y), a4 = bf_lo(v.z), a5 = bf_hi(v.z), a6 = bf_lo(v.w), a7 = bf_hi(v.w);
        const float s = wave_sum(((a0 + a1) + (a2 + a3)) + ((a4 + a5) + (a6 + a7)));
        const float mu = s * (1.f / 512.f);
        const float d0 = a0 - mu, d1 = a1 - mu, d2 = a2 - mu, d3 = a3 - mu, d4 = a4 - mu, d5 = a5 - mu, d6 = a6 - mu, d7 = a7 - mu;
        const float q = wave_sum(((d0 * d0 + d1 * d1) + (d2 * d2 + d3 * d3)) + ((d4 * d4 + d5 * d5) + (d6 * d6 + d7 * d7)));
        if (lane == 0) { stat[2 * t] = mu; stat[2 * t + 1] = rsqrtf(q * (1.f / 512.f) + EPS); } }
    __syncthreads();
    const int wt = w & 3, wc2 = w >> 2;
    const int tt = tid >> 2, cq = tid & 3;
    for (int g = 0; g < 4; ++g) {
        { const float mu = stat[2 * tt], rs = stat[2 * tt + 1];
          const float* lg = P.sg_ln_g + l * 512 + g * 128 + cq * 32; const float* lb = P.sg_ln_b + l * 512 + g * 128 + cq * 32;
#pragma unroll
          for (int i = 0; i < 4; ++i) { const u32x4 v = *(const u32x4*)(Pj + (rowbase + tt) * NIN + C_VS + g * 128 + cq * 32 + i * 8);
              const float a[8] = {bf_lo(v.x), bf_hi(v.x), bf_lo(v.y), bf_hi(v.y), bf_lo(v.z), bf_hi(v.z), bf_lo(v.w), bf_hi(v.w)};
#pragma unroll
              for (int e = 0; e < 8; ++e) { const float o = (a[e] - mu) * rs * lg[i * 8 + e] + lb[i * 8 + e];
                  T[(cq * 32 + i * 8 + e) * 136 + tt] = (bf16_t)(cvt_pk_bf16(o, 0.f) & 0xffffu); } } }
        __syncthreads();
        f32x16 acc[2];
#pragma unroll
        for (int r = 0; r < 16; ++r) { acc[0][r] = 0.f; acc[1][r] = 0.f; }
        for (int ks = 0; ks < 2 * (wt + 1); ++ks) {
            const bf16x8 af = *(const bf16x8*)(sgw + (size_t)(g * 128 + 32 * wt + r32) * 128 + 16 * ks + 8 * hi);
#pragma unroll
            for (int cb = 0; cb < 2; ++cb) { const bf16x8 bfv = *(const LAS bf16x8*)(T + (64 * wc2 + 32 * cb + r32) * 136 + 16 * ks + 8 * hi); acc[cb] = MFMA32(af, bfv, acc[cb]); } }
        const float* bs = P.sg_b + (size_t)l * 512 + g * 128;
#pragma unroll
        for (int cb = 0; cb < 2; ++cb)
#pragma unroll
            for (int r = 0; r < 16; ++r) { const int t = 32 * wt + crow(r, hi); bf16_t* up = Pj + (rowbase + t) * NIN + C_U + g * 128 + 64 * wc2 + 32 * cb + r32;
                const float uv = __uint_as_float((unsigned)(*up) << 16); *up = (bf16_t)(cvt_pk_bf16(uv * (acc[cb][r] + bs[t]), 0.f) & 0xffffu); }
        __syncthreads();
    }
    for (int g = 0; g < 4; ++g) {
        const int win = 2 << g; const int tpos = ck * 128 + tt; const int cnt = (tpos + 1 < win) ? tpos + 1 : win; const float inv = 1.0f / (float)cnt;
#pragma unroll
        for (int i = 0; i < 4; ++i) { const bf16_t* xp = Pj + (rowbase + tt) * NIN + C_XP + g * 128 + cq * 32 + i * 8;
            float s[8]; float x0[8];
            { const u32x4 v = *(const u32x4*)xp; x0[0] = bf_lo(v.x); x0[1] = bf_hi(v.x); x0[2] = bf_lo(v.y); x0[3] = bf_hi(v.y); x0[4] = bf_lo(v.z); x0[5] = bf_hi(v.z); x0[6] = bf_lo(v.w); x0[7] = bf_hi(v.w); }
#pragma unroll
            for (int e = 0; e < 8; ++e) s[e] = x0[e];
            for (int j = 1; j < cnt; ++j) { const u32x4 v = *(const u32x4*)(xp - (size_t)j * NIN);
                s[0] += bf_lo(v.x); s[1] += bf_hi(v.x); s[2] += bf_lo(v.y); s[3] += bf_hi(v.y); s[4] += bf_lo(v.z); s[5] += bf_hi(v.z); s[6] += bf_lo(v.w); s[7] += bf_hi(v.w); }
            u32x4 o; o.x = cvt_pk_bf16(s[0] * inv - x0[0], s[1] * inv - x0[1]); o.y = cvt_pk_bf16(s[2] * inv - x0[2], s[3] * inv - x0[3]);
            o.z = cvt_pk_bf16(s[4] * inv - x0[4], s[5] * inv - x0[5]); o.w = cvt_pk_bf16(s[6] * inv - x0[6], s[7] * inv - x0[7]);
            *(LAS u32x4*)(T + tt * 136 + cq * 32 + i * 8) = o; }
        __syncthreads();
        f32x16 acc[2];
#pragma unroll
        for (int r = 0; r < 16; ++r) { acc[0][r] = 0.f; acc[1][r] = 0.f; }
#pragma unroll
        for (int ks = 0; ks < 8; ++ks) {
            const bf16x8 af = *(const LAS bf16x8*)(T + (32 * wt + r32) * 136 + 16 * ks + 8 * hi);
#pragma unroll
            for (int cb = 0; cb < 2; ++cb) { const bf16x8 bfv = *(const bf16x8*)(plw + (size_t)(g * 128 + 64 * wc2 + 32 * cb + r32) * 128 + 16 * ks + 8 * hi); acc[cb] = MFMA32(af, bfv, acc[cb]); } }
#pragma unroll
        for (int cb = 0; cb < 2; ++cb) { const float sc = P.pool_scale[l * 512 + g * 128 + 64 * wc2 + 32 * cb + r32];
#pragma unroll
            for (int r = 0; r < 16; ++r) { const int t = 32 * wt + crow(r, hi);
                Pj[(rowbase + t) * NIN + C_VS + g * 128 + 64 * wc2 + 32 * cb + r32] = (bf16_t)(cvt_pk_bf16(acc[cb][r] * sc, 0.f) & 0xffffu); } }
        __syncthreads();
    }
}
__device__ __forceinline__ void conv_geglu(const bf16_t* up, bf16_t* act, const float* cw, const float* cb, int gtid, int NGT) {
    constexpr int NCH = DFF / 8, NRB = MH / 16;
    for (int it = gtid; it < NRB * NCH; it += NGT) {
        const int rb = it / NCH, ch = it % NCH, t0 = rb * 16, c0 = ch * 8;
        float wg[3][8], wv[3][8], bg[8], bv[8];
#pragma unroll
        for (int e = 0; e < 8; ++e) { bg[e] = cb[c0 + e]; bv[e] = cb[DFF + c0 + e];
#pragma unroll
            for (int i = 0; i < 3; ++i) { wg[i][e] = cw[i * NUP + c0 + e]; wv[i][e] = cw[i * NUP + DFF + c0 + e]; } }
        float g2[8], g1[8], v2[8], v1[8];
#pragma unroll
        for (int e = 0; e < 8; ++e) { g2[e] = 0.f; g1[e] = 0.f; v2[e] = 0.f; v1[e] = 0.f; }
        if ((t0 & (SEQ - 1)) != 0) {
            const u32x4 a = *(const u32x4*)(up + (size_t)(t0 - 2) * NUP + c0), bq = *(const u32x4*)(up + (size_t)(t0 - 1) * NUP + c0);
            const u32x4 c = *(const u32x4*)(up + (size_t)(t0 - 2) * NUP + DFF + c0), d = *(const u32x4*)(up + (size_t)(t0 - 1) * NUP + DFF + c0);
            g2[0] = bf_lo(a.x); g2[1] = bf_hi(a.x); g2[2] = bf_lo(a.y); g2[3] = bf_hi(a.y); g2[4] = bf_lo(a.z); g2[5] = bf_hi(a.z); g2[6] = bf_lo(a.w); g2[7] = bf_hi(a.w);
            g1[0] = bf_lo(bq.x); g1[1] = bf_hi(bq.x); g1[2] = bf_lo(bq.y); g1[3] = bf_hi(bq.y); g1[4] = bf_lo(bq.z); g1[5] = bf_hi(bq.z); g1[6] = bf_lo(bq.w); g1[7] = bf_hi(bq.w);
            v2[0] = bf_lo(c.x); v2[1] = bf_hi(c.x); v2[2] = bf_lo(c.y); v2[3] = bf_hi(c.y); v2[4] = bf_lo(c.z); v2[5] = bf_hi(c.z); v2[6] = bf_lo(c.w); v2[7] = bf_hi(c.w);
            v1[0] = bf_lo(d.x); v1[1] = bf_hi(d.x); v1[2] = bf_lo(d.y); v1[3] = bf_hi(d.y); v1[4] = bf_lo(d.z); v1[5] = bf_hi(d.z); v1[6] = bf_lo(d.w); v1[7] = bf_hi(d.w);
        }
        for (int t = t0; t < t0 + 16; ++t) {
            const u32x4 a = *(const u32x4*)(up + (size_t)t * NUP + c0), c = *(const u32x4*)(up + (size_t)t * NUP + DFF + c0);
            const float g0[8] = {bf_lo(a.x), bf_hi(a.x), bf_lo(a.y), bf_hi(a.y), bf_lo(a.z), bf_hi(a.z), bf_lo(a.w), bf_hi(a.w)};
            const float v0[8] = {bf_lo(c.x), bf_hi(c.x), bf_lo(c.y), bf_hi(c.y), bf_lo(c.z), bf_hi(c.z), bf_lo(c.w), bf_hi(c.w)};
            float o[8];
#pragma unroll
            for (int e = 0; e < 8; ++e) { const float gt = bg[e] + wg[0][e] * g2[e] + wg[1][e] * g1[e] + wg[2][e] * g0[e]; const float vl = bv[e] + wv[0][e] * v2[e] + wv[1][e] * v1[e] + wv[2][e] * v0[e];
                o[e] = pg8::gelu_tanh_f(gt) * vl; g2[e] = g1[e]; g1[e] = g0[e]; v2[e] = v1[e]; v1[e] = v0[e]; }
            u32x4 ow; ow.x = cvt_pk_bf16(o[0], o[1]); ow.y = cvt_pk_bf16(o[2], o[3]); ow.z = cvt_pk_bf16(o[4], o[5]); ow.w = cvt_pk_bf16(o[6], o[7]);
            *(u32x4*)(act + (size_t)t * DFF + c0) = ow;
        }
    }
}
}
using namespace mk;
struct Args { Ptrs p; int ph_lo, ph_hi; };
constexpr int N_PHASES = 1 + 11 * NLAYER;

__global__ void __launch_bounds__(512, 2) mega_fwd(Args args) {
    extern __shared__ __attribute__((aligned(16))) unsigned char lds_raw[];
    LAS unsigned char* lds = (LAS unsigned char*)lds_raw;
    cg::grid_group grid = cg::this_grid();
    const Ptrs& P = args.p;
    const int G = gridDim.x, bid = blockIdx.x;
    const int lo = args.ph_lo, hi = args.ph_hi;
    int ph = 0;
#define FRESH const int tid = pg8::fresh_tid(), lane = tid & 63, wave = __builtin_amdgcn_readfirstlane(tid >> 6); const int gw = bid * 8 + wave, NGW = G * 8, gtid = bid * 512 + tid, NGT = G * 512; \
    unsigned char* ws = pg8::fresh_ptr(P.ws); (void)lane; (void)gw; (void)NGW; (void)gtid; (void)NGT; \
    bf16_t* W_IN = (bf16_t*)(ws + WS_WIN); bf16_t* W_BR = (bf16_t*)(ws + WS_WBR); bf16_t* W_OUT = (bf16_t*)(ws + WS_WOUT); bf16_t* W_UP = (bf16_t*)(ws + WS_WUP); bf16_t* W_DN = (bf16_t*)(ws + WS_WDN); \
    bf16_t* Hb = (bf16_t*)(ws + WS_H); bf16_t* Pj = (bf16_t*)(ws + WS_P); bf16_t* UPb = (bf16_t*)(ws + WS_UP); bf16_t* ACT = (bf16_t*)(ws + WS_ACT); bf16_t* Yb = (bf16_t*)(ws + WS_Y); \
    (void)W_IN; (void)W_BR; (void)W_OUT; (void)W_UP; (void)W_DN; (void)Hb; (void)Pj; (void)UPb; (void)ACT; (void)Yb;
#define RUN(k) (lo <= (k) && (k) < hi)
#define SEAM(k) do { if (lo <= (k) && (k) + 1 < hi) { asm volatile("s_waitcnt vmcnt(0)" ::: "memory"); grid.sync(); \
        if (threadIdx.x == 0) { __builtin_amdgcn_fence(__ATOMIC_ACQUIRE, "agent"); asm volatile("s_waitcnt vmcnt(0)" ::: "memory"); } __syncthreads(); } } while (0)

    if (RUN(ph)) { FRESH
        convert_weights(P, 0, lds, gw, NGW, lane, gtid, NGT);
        for (int m = gw; m < MTOK; m += NGW) norm_row(P.x + (size_t)m * DM, P.norm_pre_mix, Hb + (size_t)m * DM, lane);
    }
    SEAM(ph); ++ph;
    for (int l = 0; l < NLAYER; ++l) {
        const float* xin = (l == 0) ? P.x : P.out;
        if (RUN(ph)) { FRESH
            pg8::Gemm g{Hb, W_IN, MTOK, NIN, DM, DM, DM}; pg8::StaticOrder S; S.init(MTOK, NIN, G, bid);
            pg8::EpiProj E{Pj, NIN, QSCALE};
            pg8::gemm_phase<pg8::EpiProj, pg8::StaticOrder, true, true>(lds, g, S, E);
        }
        SEAM(ph); ++ph;
        if (RUN(ph)) { FRESH
            for (int it = bid; it < 1024 + 256; it += G) {
                if (it < 1024) { const int bh = it & 63, qb = 15 - (it >> 6); attn_unit(lds, Pj, bh >> 3, bh & 7, qb); }
                else { const int u = it - 1024; sgp_unit(lds, P, l, Pj, u >> 5, u & 31); }
            }
        }
        SEAM(ph); ++ph;
        if (RUN(ph)) { FRESH
            pg8::StaticOrder S; S.init(MTOK, DM, G, bid);
            { pg8::Gemm g{Pj + C_Q, W_BR, MTOK, DM, 512, NIN, 512}; pg8::EpiMerge<1> E{Hb, DM, Pj + C_G, NIN}; pg8::gemm_phase<pg8::EpiMerge<1>, pg8::StaticOrder, true, true>(lds, g, S, E); }
            { pg8::Gemm g{Pj + C_U, W_BR + (size_t)DM * 512, MTOK, DM, 512, NIN, 512}; pg8::EpiMerge<0> E{Hb, DM, Pj + C_G + DM, NIN}; pg8::gemm_phase<pg8::EpiMerge<0>, pg8::StaticOrder, true, true>(lds, g, S, E); }
            { pg8::Gemm g{Pj + C_VS, W_BR + (size_t)2 * DM * 512, MTOK, DM, 512, NIN, 512}; pg8::EpiMerge<0> E{Hb, DM, Pj + C_G + 2 * DM, NIN}; pg8::gemm_phase<pg8::EpiMerge<0>, pg8::StaticOrder, true, true>(lds, g, S, E); }
        }
        SEAM(ph); ++ph;
        if (RUN(ph)) { FRESH
            pg8::Gemm g{Hb, W_OUT, MTOK, DM, DM, DM, DM}; pg8::StaticOrder S; S.init(MTOK, DM, G, bid);
            pg8::EpiPlain E{Yb, DM};
            pg8::gemm_phase<pg8::EpiPlain, pg8::StaticOrder, true, true>(lds, g, S, E);
        }
        SEAM(ph); ++ph;
        if (RUN(ph)) { FRESH
            for (int m = gw; m < MTOK; m += NGW) resid_row(xin + (size_t)m * DM, Yb + (size_t)m * DM, P.norm_post_mix + l * DM, P.out + (size_t)m * DM, P.norm_pre_ffn + l * DM, Hb + (size_t)m * DM, lane);
        }
        SEAM(ph); ++ph;
        for (int half = 0; half < 2; ++half) {
            if (half == 0) {
                if (RUN(ph)) { FRESH pg8::Gemm g{Hb, W_UP, MH, NUP, DM, DM, DM}; pg8::StaticOrder S; S.init(MH, NUP, G, bid); pg8::EpiPlain E{UPb, NUP};
                    pg8::gemm_phase<pg8::EpiPlain, pg8::StaticOrder, true, true>(lds, g, S, E); }
                SEAM(ph); ++ph;
            }
            if (RUN(ph)) { FRESH conv_geglu(UPb, ACT, P.conv_w + (size_t)l * 3 * NUP, P.conv_b + (size_t)l * NUP, gtid, NGT); }
            SEAM(ph); ++ph;
            if (RUN(ph)) { FRESH
                { pg8::Gemm g{ACT, W_DN, MH, DM, DFF, DFF, DFF}; pg8::StaticOrder S; S.init(MH, DM, G, bid); pg8::EpiPlain E{Yb + (size_t)half * MH * DM, DM};
                  pg8::gemm_phase<pg8::EpiPlain, pg8::StaticOrder, true, true>(lds, g, S, E); }
                if (half == 0) { pg8::Gemm g{Hb + (size_t)MH * DM, W_UP, MH, NUP, DM, DM, DM}; pg8::StaticOrder S; S.init(MH, NUP, G, bid); pg8::EpiPlain E{UPb, NUP};
                  pg8::gemm_phase<pg8::EpiPlain, pg8::StaticOrder, true, true>(lds, g, S, E); }
            }
            SEAM(ph); ++ph;
        }
        if (RUN(ph)) { FRESH
            const bool more = (l + 1 < NLAYER);
            if (more) convert_weights(P, l + 1, lds, gw, NGW, lane, gtid, NGT);
            for (int m = gw; m < MTOK; m += NGW) resid_row(P.out + (size_t)m * DM, Yb + (size_t)m * DM, P.norm_post_ffn + l * DM, P.out + (size_t)m * DM, more ? P.norm_pre_mix + (l + 1) * DM : nullptr, Hb + (size_t)m * DM, lane);
        }
        SEAM(ph); ++ph;
    }
#undef RUN
#undef FRESH
#undef SEAM
}

#ifndef MK_MULTI_LAUNCH
#define MK_MULTI_LAUNCH 0
#endif
extern "C" void kernel_launch(void* const* d_in, const int* in_sizes, int n_in, void* d_out, int out_size, void* d_ws, size_t ws_size, hipStream_t stream) {
    static int grid = 0;
    if (grid == 0) {
        if (n_in != 18 || out_size != MTOK * DM || ws_size < WS_END) { fprintf(stderr, "kernel_launch: unexpected shapes (n_in %d out %d ws %zu)\n", n_in, out_size, ws_size); grid = -1; return; }
        int dev = 0, cus = 0, per_cu = 0;
        (void)hipGetDevice(&dev); (void)hipDeviceGetAttribute(&cus, hipDeviceAttributeMultiprocessorCount, dev);
        if (hipFuncSetAttribute((const void*)mega_fwd, hipFuncAttributeMaxDynamicSharedMemorySize, LDS_BYTES) != hipSuccess) { fprintf(stderr, "kernel_launch: hipFuncSetAttribute failed\n"); grid = -1; return; }
        if (hipOccupancyMaxActiveBlocksPerMultiprocessor(&per_cu, (const void*)mega_fwd, 512, LDS_BYTES) != hipSuccess || per_cu < 1) { fprintf(stderr, "kernel_launch: occupancy query gave %d\n", per_cu); per_cu = 1; }
        (void)hipGetLastError();
        grid = cus * per_cu;
        fprintf(stderr, "kernel_launch: grid %d (cus %d x %d)\n", grid, cus, per_cu);
    }
    if (grid < 0) return;
    Args a{};
    const float** pp = (const float**)&a.p;
    for (int i = 0; i < 18; ++i) pp[i] = (const float*)d_in[i];
    a.p.out = (float*)d_out; a.p.ws = (unsigned char*)d_ws;
#if MK_MULTI_LAUNCH
    for (int k = 0; k < N_PHASES; ++k) { a.ph_lo = k; a.ph_hi = k + 1; hipLaunchKernelGGL(mega_fwd, dim3(grid), dim3(512), LDS_BYTES, stream, a); }
#else
    a.ph_lo = 0; a.ph_hi = N_PHASES;
    void* kargs[] = {&a};
    hipError_t e = hipLaunchCooperativeKernel((const void*)mega_fwd, dim3(grid), dim3(512), kargs, LDS_BYTES, stream);
    if (e != hipSuccess) fprintf(stderr, "kernel_launch: cooperative launch failed: %s (grid %d)\n", hipGetErrorString(e), grid);
#endif
}
```

```cpp
#include <hip/hip_runtime.h>
#include <hip/hip_cooperative_groups.h>
#include <cstdio>
#include <cstdint>
namespace cg = cooperative_groups;
namespace pg8 {
#define PG8_LAS __attribute__((address_space(3)))
typedef unsigned short bf16_t;
typedef short bf16x8 __attribute__((ext_vector_type(8)));
typedef float f32x4 __attribute__((ext_vector_type(4)));
typedef unsigned u32x4 __attribute__((ext_vector_type(4)));
__device__ __forceinline__ int fresh_tid() { int t = threadIdx.x; asm volatile("" : "+v"(t)); return t; }
template <class T> __device__ __forceinline__ T* fresh_ptr(T* p) { asm volatile("" : "+s"(p)); return p; }
constexpr int BM = 256, BK = 64, HALF = 128, HTB = HALF * BK * 2  , STAGE_BYTES = 8 * HTB, NXCD = 8, WGM = 8;

__host__ __device__ __forceinline__ int lds_byte(int r, int c) { const int st = (r >> 4) * 2 + (c >> 5), rr = r & 15, cc = c & 31, ob = rr * 64 + cc * 2; return st * 1024 + (ob ^ (((ob >> 9) & 1) << 5)); }
__host__ __device__ __forceinline__ void stage_rc(int b, int& R, int& C) { const int st = b / 1024, sb = b % 1024, swz = sb ^ (((sb >> 9) & 1) << 5); R = (st >> 1) * 16 + swz / 64; C = (st & 1) * 32 + (swz % 64) / 2; }
__host__ __device__ __forceinline__ int perm32(int rho) { const int n = rho >> 4, i = rho & 15; return 8 * (i >> 2) + 4 * n + (i & 3); }

struct Unit { int pm, pn; };
struct Gemm { const bf16_t* A; const bf16_t* Bt; int M, N, K, lda, ldb, ovl; };
__device__ __forceinline__ long a_row0(const Gemm& g, int pm) { return g.ovl ? (long)(pm / 17) * 4096 + 254 * (pm % 17) - 2 : (long)pm * 256; }

struct StaticOrder {
    int nM, nN, nwg, G, c;
    __host__ __device__ void init(int M, int N, int G_, int c_) { nM = M / BM; nN = N / BM; nwg = nM * nN; G = G_; c = c_; }
    __host__ __device__ bool next(int i, Unit& u) const {
        const long L = (long)i * G + c; if (L >= nwg) return false;
        int wgid = (int)L; { const int q = nwg / NXCD, r = nwg % NXCD, xcd = wgid % NXCD, off = wgid / NXCD; wgid = (xcd < r ? xcd * (q + 1) : r * (q + 1) + (xcd - r) * q) + off; }
        const int nig = WGM * nN, gid = wgid / nig, fm = gid * WGM, gsz = (nM - fm) < WGM ? (nM - fm) : WGM;
        u.pm = fm + ((wgid % nig) % gsz); u.pn = (wgid % nig) / gsz; return true;
    }
    __device__ __forceinline__ void a_ready(const Unit&) const {}
    __device__ __forceinline__ void done(const Unit&) const {}
};

typedef unsigned u32x2 __attribute__((ext_vector_type(2)));
typedef float f32x2_t __attribute__((ext_vector_type(2))); typedef __bf16 bf16x2_t __attribute__((ext_vector_type(2)));
__device__ __forceinline__ unsigned cvt_pk_bf16(float lo, float hi) { f32x2_t v = {lo, hi}; bf16x2_t b = __builtin_convertvector(v, bf16x2_t); return __builtin_bit_cast(unsigned, b); }
__device__ __forceinline__ float bf_lo(unsigned w) { return __uint_as_float(w << 16); }
__device__ __forceinline__ float bf_hi(unsigned w) { return __uint_as_float(w & 0xffff0000u); }
__device__ __forceinline__ float gelu_tanh_f(float x) { const float t = x * (1.0f + 0.044715f * x * x); return x * __builtin_amdgcn_rcpf(1.0f + __builtin_amdgcn_exp2f(-2.3022082f * t)); }
__device__ __forceinline__ float sigmoid_f(float x) { return __builtin_amdgcn_rcpf(1.0f + __builtin_amdgcn_exp2f(-1.4426950409f * x)); }

struct EpiPlain {
    static constexpr bool PERM = true, AFTER_DRAIN = false;
    bf16_t* O; int ldc;
    __device__ __forceinline__ void operator()(const f32x4 (&acc)[2][2][4][2], const Unit& u, int wr, int wc, int fr, int fq) const {
        const int row0 = u.pm * BM + wr * 64 + fr, col0 = u.pn * BM + wc * 32 + 8 * fq;
#pragma unroll
        for (int ai = 0; ai < 2; ++ai)
#pragma unroll
            for (int m = 0; m < 4; ++m) { bf16_t* rowp = O + (size_t)(row0 + ai * HALF + m * 16) * ldc + col0;
#pragma unroll
                for (int bj = 0; bj < 2; ++bj) { const f32x4 v0 = acc[ai][bj][m][0], v1 = acc[ai][bj][m][1];
                    u32x4 w; w.x = cvt_pk_bf16(v0[0], v0[1]); w.y = cvt_pk_bf16(v0[2], v0[3]); w.z = cvt_pk_bf16(v1[0], v1[1]); w.w = cvt_pk_bf16(v1[2], v1[3]);
                    *(u32x4*)(rowp + bj * HALF) = w; } }
    }
};
struct EpiProj {
    static constexpr bool PERM = true, AFTER_DRAIN = false;
    bf16_t* O; int ldc; float qscale;
    __device__ __forceinline__ void operator()(const f32x4 (&acc)[2][2][4][2], const Unit& u, int wr, int wc, int fr, int fq) const {
        const int row0 = u.pm * BM + wr * 64 + fr, col0 = u.pn * BM + wc * 32 + 8 * fq;
        const int sec = u.pn >> 1; const int mode = (sec == 0) ? 1 : (sec == 3 || sec == 4) ? 2 : (sec >= 6) ? 3 : 0;
#pragma unroll
        for (int ai = 0; ai < 2; ++ai)
#pragma unroll
            for (int m = 0; m < 4; ++m) { bf16_t* rowp = O + (size_t)(row0 + ai * HALF + m * 16) * ldc + col0;
#pragma unroll
                for (int bj = 0; bj < 2; ++bj) { f32x4 v0 = acc[ai][bj][m][0], v1 = acc[ai][bj][m][1];
                    if (mode == 1) { v0 = v0 * qscale; v1 = v1 * qscale; }
                    else if (mode == 2) {
#pragma unroll
                        for (int e = 0; e < 4; ++e) { v0[e] = gelu_tanh_f(v0[e]); v1[e] = gelu_tanh_f(v1[e]); } }
                    else if (mode == 3) {
#pragma unroll
                        for (int e = 0; e < 4; ++e) { v0[e] = sigmoid_f(v0[e]); v1[e] = sigmoid_f(v1[e]); } }
                    u32x4 w; w.x = cvt_pk_bf16(v0[0], v0[1]); w.y = cvt_pk_bf16(v0[2], v0[3]); w.z = cvt_pk_bf16(v1[0], v1[1]); w.w = cvt_pk_bf16(v1[2], v1[3]);
                    *(u32x4*)(rowp + bj * HALF) = w; } }
    }
};
template <int FIRST> struct EpiMerge {
    static constexpr bool PERM = true, AFTER_DRAIN = false;
    bf16_t* Mg; int ldm; const bf16_t* G; int ldg;
    __device__ __forceinline__ void operator()(const f32x4 (&acc)[2][2][4][2], const Unit& u, int wr, int wc, int fr, int fq) const {
        const int row0 = u.pm * BM + wr * 64 + fr, col0 = u.pn * BM + wc * 32 + 8 * fq;
#pragma unroll
        for (int ai = 0; ai < 2; ++ai)
#pragma unroll
            for (int m = 0; m < 4; ++m) { const size_t row = (size_t)(row0 + ai * HALF + m * 16);
#pragma unroll
                for (int bj = 0; bj < 2; ++bj) { f32x4 v0 = acc[ai][bj][m][0], v1 = acc[ai][bj][m][1];
                    const u32x4 gw = *(const u32x4*)(G + row * ldg + col0 + bj * HALF);
                    v0[0] *= bf_lo(gw.x); v0[1] *= bf_hi(gw.x); v0[2] *= bf_lo(gw.y); v0[3] *= bf_hi(gw.y);
                    v1[0] *= bf_lo(gw.z); v1[1] *= bf_hi(gw.z); v1[2] *= bf_lo(gw.w); v1[3] *= bf_hi(gw.w);
                    bf16_t* mp = Mg + row * ldm + col0 + bj * HALF;
                    if (!FIRST) { const u32x4 ow = *(const u32x4*)mp;
                        v0[0] += bf_lo(ow.x); v0[1] += bf_hi(ow.x); v0[2] += bf_lo(ow.y); v0[3] += bf_hi(ow.y);
                        v1[0] += bf_lo(ow.z); v1[1] += bf_hi(ow.z); v1[2] += bf_lo(ow.w); v1[3] += bf_hi(ow.w); }
                    u32x4 w; w.x = cvt_pk_bf16(v0[0], v0[1]); w.y = cvt_pk_bf16(v0[2], v0[3]); w.z = cvt_pk_bf16(v1[0], v1[1]); w.w = cvt_pk_bf16(v1[2], v1[3]);
                    *(u32x4*)mp = w; } }
    }
};


#define PG8_DPP(v, ctrl) __int_as_float(__builtin_amdgcn_update_dpp(0, __float_as_int(v), (ctrl), 0xf, 0xf, true))
struct EpiGeglu {
    static constexpr bool PERM = true, AFTER_DRAIN = false;
    bf16_t* ACT; const float* cw; const float* cb; PG8_LAS f32x4* halo; int nup, dff;
    __device__ __forceinline__ void operator()(const f32x4 (&acc)[2][2][4][2], const Unit& u, int wr, int wc, int fr, int fq) const {
        const int w = wr * 4 + wc; const int bb = u.pm / 17, ti = u.pm - bb * 17;
        if (fr >= 14) {
#pragma unroll
            for (int ai = 0; ai < 2; ++ai)
#pragma unroll
                for (int bj = 0; bj < 2; ++bj)
#pragma unroll
                    for (int n = 0; n < 2; ++n) halo[((((w * 2 + ai) * 2 + (fr - 14)) * 4 + fq) * 4) + bj * 2 + n] = acc[ai][bj][3][n];
        }
        asm volatile("s_waitcnt lgkmcnt(0)" ::: "memory"); __builtin_amdgcn_s_barrier(); asm volatile("" ::: "memory");
        const int colh = u.pn * 128 + wc * 32 + 8 * fq;
#pragma unroll
        for (int n = 0; n < 2; ++n) {
            const int c = colh + 4 * n;
            const f32x4 w0g = *(const f32x4*)(cw + c), w1g = *(const f32x4*)(cw + nup + c), w2g = *(const f32x4*)(cw + 2 * nup + c), bg = *(const f32x4*)(cb + c);
            const f32x4 w0v = *(const f32x4*)(cw + dff + c), w1v = *(const f32x4*)(cw + nup + dff + c), w2v = *(const f32x4*)(cw + 2 * nup + dff + c), bv = *(const f32x4*)(cb + dff + c);
#pragma unroll
            for (int ai = 0; ai < 2; ++ai) {
                f32x4 pgG = (f32x4){0.f, 0.f, 0.f, 0.f}, pgV = (f32x4){0.f, 0.f, 0.f, 0.f};
                { int sw = -1, sai = 0; if (wr == 1) { sw = wc; sai = ai; } else if (ai == 1) { sw = 4 + wc; sai = 0; }
                  if (sw >= 0 && fr >= 14) { const int idx = ((((sw * 2 + sai) * 2 + (fr - 14)) * 4 + fq) * 4); pgG = halo[idx + n]; pgV = halo[idx + 2 + n]; } }
#pragma unroll
                for (int m = 0; m < 4; ++m) {
                    f32x4 cg = acc[ai][0][m][n], cv = acc[ai][1][m][n];
                    const f32x4 pG = (m == 0) ? pgG : acc[ai][0][m == 0 ? 0 : m - 1][n], pV = (m == 0) ? pgV : acc[ai][1][m == 0 ? 0 : m - 1][n];
                    const int rl = 128 * ai + 64 * wr + 16 * m + fr, t = 254 * ti - 2 + rl;
                    if (t < 0) { cg = (f32x4){0.f, 0.f, 0.f, 0.f}; cv = (f32x4){0.f, 0.f, 0.f, 0.f}; }
                    float o[4];
#pragma unroll
                    for (int e = 0; e < 4; ++e) {
                        const float g1 = PG8_DPP(cg[e], 0x111) + PG8_DPP(pG[e], 0x10F), g2 = PG8_DPP(cg[e], 0x112) + PG8_DPP(pG[e], 0x10E);
                        const float v1 = PG8_DPP(cv[e], 0x111) + PG8_DPP(pV[e], 0x10F), v2 = PG8_DPP(cv[e], 0x112) + PG8_DPP(pV[e], 0x10E);
                        const float gt = bg[e] + w0g[e] * g2 + w1g[e] * g1 + w2g[e] * cg[e];
                        const float vl = bv[e] + w0v[e] * v2 + w1v[e] * v1 + w2v[e] * cv[e];
                        o[e] = gelu_tanh_f(gt) * vl; }
                    if (rl >= 2 && t < 4096) { u32x2 ow; ow.x = cvt_pk_bf16(o[0], o[1]); ow.y = cvt_pk_bf16(o[2], o[3]);
                        *(u32x2*)(ACT + ((size_t)bb * 4096 + t) * dff + c) = ow; }
                }
            }
        }
    }
};
template <class Epi, class Sched, bool ALIGN_EPI = false, bool SP2 = false>
__device__ __forceinline__ void gemm_phase(PG8_LAS unsigned char* lds, const Gemm g, const Sched& S, const Epi& E) {
    const int tid = fresh_tid(), wid = __builtin_amdgcn_readfirstlane(tid >> 6), lane = tid & 63, wr = wid >> 2, wc = wid & 3, fr = lane & 15, fq = lane >> 4;
    const int K = g.K, nt = K / BK;
    unsigned voffA[2], voffB[2];
#pragma unroll
    for (int i = 0; i < 2; ++i) { int R, C; stage_rc(tid * 16 + i * 8192, R, C); const int Rb = Epi::PERM ? ((R & ~31) + perm32(R & 31)) : R;
        voffA[i] = (unsigned)(R * g.lda + C) * 2u; voffB[i] = (unsigned)(Rb * g.ldb + C) * 2u; }
    const size_t kstep = (size_t)(BK * 2);
    const size_t hstepA = (size_t)HALF * g.lda * 2, hstepB = (size_t)HALF * g.ldb * 2;
    const size_t tstepB = 2 * hstepB;
    const unsigned ldsw = (unsigned)wid * 1024u;
    const int aoff = lds_byte(wr * 64 + fr, fq * 8), boff = lds_byte(wc * 32 + fr, fq * 8);
#define PG8_SA(b, h) (((b) * 2 + (h)) * HTB)
#define PG8_SB(b, h) ((4 + (b) * 2 + (h)) * HTB)
#define PG8_STAGE(bufoff, gbase, voff) do { _Pragma("unroll") for (int _i = 0; _i < 2; ++_i) \
        __builtin_amdgcn_global_load_lds((const unsigned*)((const char*)(gbase) + (voff)[_i]), (PG8_LAS unsigned*)(lds + (bufoff) + ldsw + _i * 8192), 16, 0, 0); } while (0)
#define PG8_LDA(dst, b, h) do { _Pragma("unroll") for (int m = 0; m < 4; ++m) _Pragma("unroll") for (int k = 0; k < 2; ++k) dst[m][k] = *(const PG8_LAS bf16x8*)(lds + PG8_SA(b, h) + aoff + m * 2048 + k * 1024); } while (0)
#define PG8_LDB(dst, b, h) do { _Pragma("unroll") for (int n = 0; n < 2; ++n) _Pragma("unroll") for (int k = 0; k < 2; ++k) dst[n][k] = *(const PG8_LAS bf16x8*)(lds + PG8_SB(b, h) + boff + n * 2048 + k * 1024); } while (0)
#define PG8_MMA(ai, bj, At, Bt) do { __builtin_amdgcn_s_setprio(1); _Pragma("unroll") for (int m = 0; m < 4; ++m) _Pragma("unroll") for (int n = 0; n < 2; ++n) _Pragma("unroll") for (int k = 0; k < 2; ++k) \
        acc[ai][bj][m][n] = __builtin_amdgcn_mfma_f32_16x16x32_bf16(Bt[n][k], At[m][k], acc[ai][bj][m][n], 0, 0, 0); __builtin_amdgcn_s_setprio(0); } while (0)
#define PG8_WAIT_V(n) asm volatile("s_waitcnt vmcnt(" #n ")" ::: "memory")
#define PG8_WAIT_L(n) asm volatile("s_waitcnt lgkmcnt(" #n ")" ::: "memory")
#define PG8_BAR __builtin_amdgcn_s_barrier()
#define PG8_SCHED __builtin_amdgcn_sched_barrier(0)
    Unit cur, nxt; int ui = 0;
    if (!S.next(0, cur)) return;
    f32x4 acc[2][2][4][2];
#pragma unroll
    for (int a = 0; a < 2; ++a)
#pragma unroll
        for (int b = 0; b < 2; ++b)
#pragma unroll
            for (int m = 0; m < 4; ++m)
#pragma unroll
                for (int n = 0; n < 2; ++n) acc[a][b][m][n] = (f32x4){0.f, 0.f, 0.f, 0.f};
    bf16x8 At[4][2], B0[2][2], B1[2][2];
    const char* cA = (const char*)g.A + a_row0(g, cur.pm) * (long)(g.lda * 2); const char* cB = (const char*)g.Bt + (size_t)cur.pn * tstepB;
    S.a_ready(cur);
    if constexpr (SP2) {
        PG8_STAGE(PG8_SB(0, 0), cB, voffB); PG8_STAGE(PG8_SB(0, 1), cB + hstepB, voffB); PG8_STAGE(PG8_SA(0, 0), cA, voffA); PG8_STAGE(PG8_SA(0, 1), cA + hstepA, voffA);
        if (wr == 1) PG8_BAR;
        PG8_WAIT_V(2); PG8_BAR;
        PG8_STAGE(PG8_SB(1, 0), cB + kstep, voffB); PG8_STAGE(PG8_SA(1, 0), cA + kstep, voffA); PG8_STAGE(PG8_SB(1, 1), cB + hstepB + kstep, voffB);
        PG8_WAIT_V(6); PG8_BAR;
    } else {
        PG8_STAGE(PG8_SB(0, 0), cB, voffB); PG8_STAGE(PG8_SA(0, 0), cA, voffA); PG8_STAGE(PG8_SB(0, 1), cB + hstepB, voffB); PG8_STAGE(PG8_SA(0, 1), cA + hstepA, voffA);
        if (wr == 1) PG8_BAR;
        PG8_WAIT_V(4); PG8_BAR;
        PG8_STAGE(PG8_SB(1, 0), cB + kstep, voffB); PG8_STAGE(PG8_SA(1, 0), cA + kstep, voffA); PG8_STAGE(PG8_SB(1, 1), cB + hstepB + kstep, voffB);
        PG8_WAIT_V(6); PG8_BAR;
    }
    for (;;) {
        const bool has_next = S.next(ui + 1, nxt);
        const char* nA = has_next ? (const char*)g.A + a_row0(g, nxt.pm) * (long)(g.lda * 2) : cA; const char* nB = has_next ? (const char*)g.Bt + (size_t)nxt.pn * tstepB : cB;
        for (int t = 0; t < nt; t += 2) {
            const bool last = (t == nt - 2);
            const char* a1 = cA + (size_t)(t + 1) * kstep;
            const char* a2 = last ? nA : cA + (size_t)(t + 2) * kstep; const char* b2 = last ? nB : cB + (size_t)(t + 2) * kstep;
            const char* a3 = a2 + kstep; const char* b3 = b2 + kstep;
            if (last && has_next) S.a_ready(nxt);
            if constexpr (SP2) {
            PG8_LDB(B0, 0, 0); PG8_LDB(B1, 0, 1); PG8_SCHED; PG8_LDA(At, 0, 0); PG8_STAGE(PG8_SA(1, 1), a1 + hstepA, voffA);
            PG8_WAIT_V(8); PG8_WAIT_L(0); PG8_BAR; PG8_MMA(0, 0, At, B0); PG8_MMA(0, 1, At, B1); PG8_BAR; PG8_SCHED;
            PG8_LDA(At, 0, 1); PG8_STAGE(PG8_SB(0, 0), b2, voffB); PG8_STAGE(PG8_SB(0, 1), b2 + hstepB, voffB); PG8_STAGE(PG8_SA(0, 0), a2, voffA);
            PG8_WAIT_V(8); PG8_WAIT_L(0); PG8_BAR; PG8_MMA(1, 0, At, B0); PG8_MMA(1, 1, At, B1); PG8_BAR; PG8_SCHED;
            PG8_LDB(B0, 1, 0); PG8_LDB(B1, 1, 1); PG8_SCHED; PG8_LDA(At, 1, 0); PG8_STAGE(PG8_SA(0, 1), a2 + hstepA, voffA);
            PG8_WAIT_V(8); PG8_WAIT_L(0); PG8_BAR; PG8_MMA(0, 0, At, B0); PG8_MMA(0, 1, At, B1); PG8_BAR; PG8_SCHED;
            PG8_LDA(At, 1, 1); PG8_STAGE(PG8_SB(1, 0), b3, voffB); PG8_STAGE(PG8_SB(1, 1), b3 + hstepB, voffB); PG8_STAGE(PG8_SA(1, 0), a3, voffA);
            PG8_WAIT_V(8); PG8_WAIT_L(0); PG8_BAR; PG8_MMA(1, 0, At, B0); PG8_MMA(1, 1, At, B1); PG8_BAR; PG8_SCHED;
            } else {
            PG8_LDB(B0, 0, 0); PG8_SCHED; PG8_LDA(At, 0, 0); PG8_STAGE(PG8_SA(1, 1), a1 + hstepA, voffA);
            PG8_WAIT_L(8); PG8_BAR; PG8_WAIT_L(0); PG8_MMA(0, 0, At, B0); PG8_BAR; PG8_SCHED;
            PG8_LDB(B1, 0, 1); PG8_STAGE(PG8_SB(0, 0), b2, voffB);
            PG8_BAR; PG8_WAIT_L(0); PG8_MMA(0, 1, At, B1); PG8_BAR;
            PG8_LDA(At, 0, 1); PG8_STAGE(PG8_SA(0, 0), a2, voffA);
            PG8_BAR; PG8_WAIT_L(0); PG8_MMA(1, 0, At, B0); PG8_BAR; PG8_SCHED;
            PG8_STAGE(PG8_SB(0, 1), b2 + hstepB, voffB);
            PG8_WAIT_V(6); PG8_BAR; PG8_MMA(1, 1, At, B1); PG8_BAR;
            PG8_LDB(B0, 1, 0); PG8_SCHED; PG8_LDA(At, 1, 0); PG8_STAGE(PG8_SA(0, 1), a2 + hstepA, voffA);
            PG8_WAIT_L(8); PG8_BAR; PG8_WAIT_L(0); PG8_MMA(0, 0, At, B0); PG8_BAR; PG8_SCHED;
            PG8_LDB(B1, 1, 1); PG8_STAGE(PG8_SB(1, 0), b3, voffB);
            PG8_BAR; PG8_WAIT_L(0); PG8_MMA(0, 1, At, B1); PG8_BAR;
            PG8_LDA(At, 1, 1); PG8_STAGE(PG8_SA(1, 0), a3, voffA);
            PG8_BAR; PG8_WAIT_L(0); PG8_MMA(1, 0, At, B0); PG8_BAR; PG8_SCHED;
            PG8_STAGE(PG8_SB(1, 1), b3 + hstepB, voffB);
            PG8_WAIT_V(6); PG8_BAR; PG8_MMA(1, 1, At, B1); PG8_BAR;
            }
        }
        if constexpr (ALIGN_EPI) { if (wr == 0) PG8_BAR; }
        if constexpr (!Epi::AFTER_DRAIN) { E(acc, cur, wr, wc, fr, fq); S.done(cur); }
        if (!has_next) break;
#pragma unroll
        for (int a = 0; a < 2; ++a)
#pragma unroll
            for (int b = 0; b < 2; ++b)
#pragma unroll
                for (int m = 0; m < 4; ++m)
#pragma unroll
                    for (int n = 0; n < 2; ++n) acc[a][b][m][n] = (f32x4){0.f, 0.f, 0.f, 0.f};
        cur = nxt; cA = nA; cB = nB; ++ui;
        if constexpr (ALIGN_EPI) { if (wr == 1) PG8_BAR; }
    }
    PG8_WAIT_V(0);
    if constexpr (!ALIGN_EPI) { if (wr == 0) PG8_BAR; }
    PG8_BAR;
    if constexpr (Epi::AFTER_DRAIN) { E.fused(acc, cur, wr, wc, fr, fq, lds, wid, lane); S.done(cur); }
#undef PG8_SA
#undef PG8_SB
#undef PG8_STAGE
#undef PG8_LDA
#undef PG8_LDB
#undef PG8_MMA
#undef PG8_WAIT_V
#undef PG8_WAIT_L
#undef PG8_BAR
#undef PG8_SCHED
}
}
namespace mk {
using pg8::bf16_t; using pg8::bf16x8; using pg8::f32x4; using pg8::u32x4; using pg8::cvt_pk_bf16; using pg8::bf_lo; using pg8::bf_hi;
typedef float f32x16 __attribute__((ext_vector_type(16)));
typedef short s16x4 __attribute__((ext_vector_type(4)));
using pg8::u32x2;
#define LAS __attribute__((address_space(3)))
#define MFMA32(a, b, c) __builtin_amdgcn_mfma_f32_32x32x16_bf16((a), (b), (c), 0, 0, 0)

constexpr int NB = 8, SEQ = 4096, DM = 1024, MTOK = NB * SEQ, NIN = 6144, DFF = 2816, NUP = 5632, MH = MTOK / 2, NLAYER = 2;
constexpr int C_Q = 0, C_K = 512, C_V = 1024, C_U = 1536, C_VS = 2048, C_XP = 2560, C_G = 3072;
constexpr float EPS = 1e-6f;
constexpr float QSCALE = 0.125f * 1.4426950408889634f;
constexpr float R_STOP = 160.0f;
constexpr size_t MiB = 1u << 20;
constexpr size_t WS_WIN = 1 * MiB, WS_WBR = 13 * MiB, WS_WOUT = 16 * MiB, WS_WUP = 18 * MiB, WS_WDN = 29 * MiB, WS_SGW = 35 * MiB, WS_PLW = 35 * MiB + 512 * 1024;
constexpr size_t WS_H = 36 * MiB, WS_P = 100 * MiB, WS_END = 484 * MiB;
constexpr size_t WS_ACT = WS_P, WS_Y = WS_P + 264 * MiB;
constexpr int LDS_BYTES = 147456;

__device__ __forceinline__ int crow(int r, int hi) { return (r & 3) + 8 * (r >> 2) + 4 * hi; }
__device__ __forceinline__ float wave_sum(float v) {
#pragma unroll
    for (int o = 1; o < 64; o <<= 1) v += __shfl_xor(v, o);
    return v;
}
template <int GLU = 0> __device__ __forceinline__ void transpose_item(const float* W, int K, int N, bf16_t* WT, LAS float* scr, int item, int lane) {
    const int nblk = N / 32, kb = item / nblk, nb = item % nblk, k0 = 64 * kb, n0 = 32 * nb;
    int r0 = n0; if (GLU) { const int half = N / 2, j = (n0 < half) ? n0 : n0 - half; r0 = (j / 128) * 256 + (j % 128) + ((n0 < half) ? 0 : 128); }
#pragma unroll 8
    for (int i = 0; i < 32; ++i) { const int kk = 2 * i + (lane >> 5); scr[kk * 33 + (lane & 31)] = W[(size_t)(k0 + kk) * N + n0 + (lane & 31)]; }
    asm volatile("s_waitcnt lgkmcnt(0)" ::: "memory");
    const int c = lane & 7;
#pragma unroll
    for (int j = 0; j < 4; ++j) { const int n = (lane >> 3) + 8 * j; const LAS float* s = scr + (8 * c) * 33 + n;
        u32x4 o; o.x = cvt_pk_bf16(s[0 * 33], s[1 * 33]); o.y = cvt_pk_bf16(s[2 * 33], s[3 * 33]); o.z = cvt_pk_bf16(s[4 * 33], s[5 * 33]); o.w = cvt_pk_bf16(s[6 * 33], s[7 * 33]);
        *(u32x4*)(WT + (size_t)(r0 + n) * K + k0 + 8 * c) = o; }
    asm volatile("s_waitcnt lgkmcnt(0)" ::: "memory");
}
struct Ptrs {
    const float *x, *norm_pre_mix, *w_in, *sg_ln_g, *sg_ln_b, *sg_w, *sg_b, *pool_w, *pool_scale, *w_branch, *w_out, *norm_post_mix, *norm_pre_ffn, *w_up, *conv_w, *conv_b, *w_down, *norm_post_ffn;
    float* out; unsigned char* ws;
};
__device__ __forceinline__ void convert_weights(const Ptrs& P, int l, LAS unsigned char* lds, int gw, int NGW, int lane, int gtid, int NGT) {
    LAS float* scr = (LAS float*)(lds + (pg8::fresh_tid() >> 6) * 16384);
    constexpr int I_IN = (DM / 64) * (NIN / 32), I_BR = (512 / 64) * (DM / 32), I_OUT = (DM / 64) * (DM / 32), I_UP = (DM / 64) * (NUP / 32), I_DN = (DFF / 64) * (DM / 32);
    constexpr int NITEMS = I_IN + 3 * I_BR + I_OUT + I_UP + I_DN;
    unsigned char* ws = P.ws;
    for (int it = gw; it < NITEMS; it += NGW) {
        int r = it;
        if (r < I_IN) { transpose_item(P.w_in + (size_t)l * DM * NIN, DM, NIN, (bf16_t*)(ws + WS_WIN), scr, r, lane); continue; } r -= I_IN;
        if (r < 3 * I_BR) { const int i = r / I_BR; transpose_item(P.w_branch + ((size_t)l * 3 + i) * 512 * DM, 512, DM, (bf16_t*)(ws + WS_WBR) + (size_t)i * DM * 512, scr, r % I_BR, lane); continue; } r -= 3 * I_BR;
        if (r < I_OUT) { transpose_item(P.w_out + (size_t)l * DM * DM, DM, DM, (bf16_t*)(ws + WS_WOUT), scr, r, lane); continue; } r -= I_OUT;
        if (r < I_UP) { transpose_item<1>(P.w_up + (size_t)l * DM * NUP, DM, NUP, (bf16_t*)(ws + WS_WUP), scr, r, lane); continue; } r -= I_UP;
        transpose_item(P.w_down + (size_t)l * DFF * DM, DFF, DM, (bf16_t*)(ws + WS_WDN), scr, r, lane);
    }
    bf16_t* sgw = (bf16_t*)(ws + WS_SGW); bf16_t* plw = (bf16_t*)(ws + WS_PLW);
    const float* sw = P.sg_w + (size_t)l * 65536; const float* pw = P.pool_w + (size_t)l * 65536;
    for (int i = gtid; i < 65536; i += NGT) {
        const int t = (i >> 7) & 127, s = i & 127; const float v = (s <= t) ? sw[i] : 0.f; sgw[i] = (bf16_t)(cvt_pk_bf16(v, 0.f) & 0xffffu);
        const int g = i >> 14, cp = (i >> 7) & 127, c = i & 127; plw[i] = (bf16_t)(cvt_pk_bf16(pw[g * 16384 + c * 128 + cp], 0.f) & 0xffffu);
    }
}
__device__ __forceinline__ void wave_sum4(float (&v)[4]) {
#pragma unroll
    for (int o = 1; o < 64; o <<= 1) {
#pragma unroll
        for (int r = 0; r < 4; ++r) v[r] += __shfl_xor(v[r], o); }
}
__device__ __forceinline__ float sq4(const f32x4 v) { return (v.x * v.x + v.y * v.y) + (v.z * v.z + v.w * v.w); }
__device__ __forceinline__ void norm_rows4(const float* x, const float* g, bf16_t* h, int m0, int lane) {
    f32x4 v[4][4]; float ss[4] = {0.f, 0.f, 0.f, 0.f};
#pragma unroll
    for (int r = 0; r < 4; ++r)
#pragma unroll
        for (int j = 0; j < 4; ++j) v[r][j] = *(const f32x4*)(x + (size_t)(m0 + r) * DM + 4 * lane + 256 * j);
#pragma unroll
    for (int r = 0; r < 4; ++r)
#pragma unroll
        for (int j = 0; j < 4; ++j) ss[r] += sq4(v[r][j]);
    wave_sum4(ss);
    f32x4 gg[4];
#pragma unroll
    for (int j = 0; j < 4; ++j) gg[j] = *(const f32x4*)(g + 4 * lane + 256 * j);
#pragma unroll
    for (int r = 0; r < 4; ++r) { const float rstd = rsqrtf(ss[r] * (1.f / DM) + EPS);
#pragma unroll
        for (int j = 0; j < 4; ++j) { const f32x4 o = v[r][j] * rstd * gg[j]; u32x2 w; w.x = cvt_pk_bf16(o.x, o.y); w.y = cvt_pk_bf16(o.z, o.w); *(u32x2*)(h + (size_t)(m0 + r) * DM + 4 * lane + 256 * j) = w; } }
}
__device__ __forceinline__ void resid_rows4(const float* xold, const bf16_t* yb, const float* gpost, float* xnew, const float* gnext, bf16_t* h, int m0, int lane) {
    f32x4 y[4][4], xo[4][4]; float ss[4] = {0.f, 0.f, 0.f, 0.f};
#pragma unroll
    for (int r = 0; r < 4; ++r)
#pragma unroll
        for (int j = 0; j < 4; ++j) { const u32x2 w = *(const u32x2*)(yb + (size_t)(m0 + r) * DM + 4 * lane + 256 * j); y[r][j] = (f32x4){bf_lo(w.x), bf_hi(w.x), bf_lo(w.y), bf_hi(w.y)};
            xo[r][j] = *(const f32x4*)(xold + (size_t)(m0 + r) * DM + 4 * lane + 256 * j); }
#pragma unroll
    for (int r = 0; r < 4; ++r)
#pragma unroll
        for (int j = 0; j < 4; ++j) ss[r] += sq4(y[r][j]);
    wave_sum4(ss);
    f32x4 gg[4];
#pragma unroll
    for (int j = 0; j < 4; ++j) gg[j] = *(const f32x4*)(gpost + 4 * lane + 256 * j);
    float s2[4] = {0.f, 0.f, 0.f, 0.f};
#pragma unroll
    for (int r = 0; r < 4; ++r) { const float rstd = rsqrtf(ss[r] * (1.f / DM) + EPS);
#pragma unroll
        for (int j = 0; j < 4; ++j) { y[r][j] = xo[r][j] + y[r][j] * rstd * gg[j]; *(f32x4*)(xnew + (size_t)(m0 + r) * DM + 4 * lane + 256 * j) = y[r][j]; s2[r] += sq4(y[r][j]); } }
    if (gnext) {
        wave_sum4(s2);
#pragma unroll
        for (int j = 0; j < 4; ++j) gg[j] = *(const f32x4*)(gnext + 4 * lane + 256 * j);
#pragma unroll
        for (int r = 0; r < 4; ++r) { const float r2 = rsqrtf(s2[r] * (1.f / DM) + EPS);
#pragma unroll
            for (int j = 0; j < 4; ++j) { const f32x4 o = y[r][j] * r2 * gg[j]; u32x2 w; w.x = cvt_pk_bf16(o.x, o.y); w.y = cvt_pk_bf16(o.z, o.w); *(u32x2*)(h + (size_t)(m0 + r) * DM + 4 * lane + 256 * j) = w; } }
    }
}
__device__ __forceinline__ void attn_unit(LAS unsigned char* lds, bf16_t* Pj, int b, int h, int qb, bool st = true) {
    const int tid = pg8::fresh_tid(), lane = tid & 63, r32 = lane & 31, hi = lane >> 5, w = __builtin_amdgcn_readfirstlane(tid >> 6);
    LAS bf16_t* Ks = (LAS bf16_t*)lds;
    LAS bf16_t* Vt = (LAS bf16_t*)(lds + 9216);
    volatile LAS int* flags = (volatile LAS int*)(lds + 18432);
    const size_t rowbase = (size_t)b * SEQ;
    const int q0 = qb * 256, qw = q0 + 32 * w, myq = qw + r32;
    bf16x8 qr[4];
    { const bf16_t* Qp = Pj + (rowbase + qw + r32) * NIN + C_Q + h * 64 + hi * 8;
#pragma unroll
      for (int d0 = 0; d0 < 4; ++d0) qr[d0] = *(const bf16x8*)(Qp + d0 * 16); }
    f32x16 o0, o1;
#pragma unroll
    for (int r = 0; r < 16; ++r) { o0[r] = 0.f; o1[r] = 0.f; }
    float R = 0.f; bool done = false;
    if (tid < 8) flags[tid] = 0;
    for (int jt = qb * 4 + 3; jt >= 0; --jt) {
        __syncthreads();
        { int f = 0;
#pragma unroll
          for (int i = 0; i < 8; ++i) f += flags[i];
          if (f == 8) break; }
        const int kv0 = jt * 64;
        { const int row = tid >> 3, ch = tid & 7;
          const bf16_t* src = Pj + (rowbase + kv0 + row) * NIN + h * 64 + ch * 8;
          const u32x4 kk = *(const u32x4*)(src + C_K); const u32x4 vv = *(const u32x4*)(src + C_V);
          *(LAS u32x4*)(Ks + row * 72 + ch * 8) = kk;
          LAS bf16_t* vd = Vt + (ch * 8) * 72 + row;
          vd[0 * 72] = (bf16_t)(vv.x & 0xffffu); vd[1 * 72] = (bf16_t)(vv.x >> 16); vd[2 * 72] = (bf16_t)(vv.y & 0xffffu); vd[3 * 72] = (bf16_t)(vv.y >> 16);
          vd[4 * 72] = (bf16_t)(vv.z & 0xffffu); vd[5 * 72] = (bf16_t)(vv.z >> 16); vd[6 * 72] = (bf16_t)(vv.w & 0xffffu); vd[7 * 72] = (bf16_t)(vv.w >> 16); }
        __syncthreads();
        if (!done && kv0 < qw + 32) {
            const bool need_mask = (kv0 + 64 > qw);
#pragma unroll
            for (int sub = 1; sub >= 0; --sub) {
                f32x16 p;
#pragma unroll
                for (int r = 0; r < 16; ++r) p[r] = 0.f;
#pragma unroll
                for (int d0 = 0; d0 < 4; ++d0) { const bf16x8 kf = *(const LAS bf16x8*)(Ks + (32 * sub + r32) * 72 + d0 * 16 + hi * 8); p = MFMA32(kf, qr[d0], p); }
                float c[16];
#pragma unroll
                for (int r = 0; r < 16; ++r) { const float zl = p[r]; const float e = __builtin_amdgcn_exp2f(-__builtin_fabsf(zl));
                    float sp = __builtin_fmaxf(zl, 0.f) + __builtin_amdgcn_logf(1.0f + e);
                    if (need_mask) { const int kv = kv0 + 32 * sub + crow(r, hi); if (kv >= myq) { sp = 0.f; p[r] = -1.0e30f; } }
                    c[r] = sp; }
                float U[4], sel[4];
#pragma unroll
                for (int g = 0; g < 4; ++g) { c[4 * g + 2] += c[4 * g + 3]; c[4 * g + 1] += c[4 * g + 2]; c[4 * g] += c[4 * g + 1];
                    const unsigned tu = __float_as_uint(c[4 * g]); auto rr = __builtin_amdgcn_permlane32_swap(tu, tu, false, false);
                    const float tlo = __uint_as_float(rr[0]), thi = __uint_as_float(rr[1]); U[g] = tlo + thi; sel[g] = hi ? 0.f : thi; }
                const float A2 = U[3], A1 = A2 + U[2], A0 = A1 + U[1];
                const float off[4] = {R + A0 + sel[0], R + A1 + sel[1], R + A2 + sel[2], R + sel[3]};
                R = R + (A0 + U[0]);
#pragma unroll
                for (int r = 0; r < 16; ++r) p[r] = __builtin_amdgcn_exp2f(p[r] - (c[r] + off[r >> 2]));
                u32x4 pw0, pw1;
                pw0.x = cvt_pk_bf16(p[0], p[1]); pw0.y = cvt_pk_bf16(p[2], p[3]); pw0.z = cvt_pk_bf16(p[4], p[5]); pw0.w = cvt_pk_bf16(p[6], p[7]);
                pw1.x = cvt_pk_bf16(p[8], p[9]); pw1.y = cvt_pk_bf16(p[10], p[11]); pw1.z = cvt_pk_bf16(p[12], p[13]); pw1.w = cvt_pk_bf16(p[14], p[15]);
                const bf16x8 pa0 = __builtin_bit_cast(bf16x8, pw0), pa1 = __builtin_bit_cast(bf16x8, pw1);
#pragma unroll
                for (int s = 0; s < 2; ++s) {
#pragma unroll
                    for (int db = 0; db < 2; ++db) { const LAS bf16_t* vp = Vt + (32 * db + r32) * 72 + 32 * sub + 16 * s + 4 * hi;
                        const s16x4 lo4 = *(const LAS s16x4*)vp, hi4 = *(const LAS s16x4*)(vp + 8);
                        const bf16x8 vf = (bf16x8){lo4[0], lo4[1], lo4[2], lo4[3], hi4[0], hi4[1], hi4[2], hi4[3]};
                        if (db == 0) o0 = MFMA32(s == 0 ? pa0 : pa1, vf, o0); else o1 = MFMA32(s == 0 ? pa0 : pa1, vf, o1); } }
            }
            float rm = R;
#pragma unroll
            for (int o = 1; o < 32; o <<= 1) rm = __builtin_fminf(rm, __shfl_xor(rm, o));
            if (rm > R_STOP) { done = true; if (lane == 0) flags[w] = 1; }
        }
    }
    if (st) { bf16_t* Op = Pj + (rowbase + qw) * NIN + C_Q + h * 64 + r32;
#pragma unroll
      for (int r = 0; r < 16; ++r) { bf16_t* rp = Op + (size_t)crow(r, hi) * NIN; rp[0] = (bf16_t)(cvt_pk_bf16(o0[r], 0.f) & 0xffffu); rp[32] = (bf16_t)(cvt_pk_bf16(o1[r], 0.f) & 0xffffu); } }
    __syncthreads();
}
__device__ __forceinline__ void sgp_unit(LAS unsigned char* lds, const Ptrs& P, int l, bf16_t* Pj, int b, int ck, bool st = true) {
    const int tid = pg8::fresh_tid(), lane = tid & 63, r32 = lane & 31, hi = lane >> 5, w = __builtin_amdgcn_readfirstlane(tid >> 6);
    LAS float* stat = (LAS float*)lds;
    LAS bf16_t* T = (LAS bf16_t*)(lds + 1024);
    const size_t rowbase = (size_t)b * SEQ + (size_t)ck * 128;
    const bf16_t* sgw = (const bf16_t*)(P.ws + WS_SGW); const bf16_t* plw = (const bf16_t*)(P.ws + WS_PLW);
    for (int i = 0; i < 16; ++i) { const int t = 16 * w + i; const u32x4 v = *(const u32x4*)(Pj + (rowbase + t) * NIN + C_VS + 8 * lane);
        const float a0 = bf_lo(v.x), a1 = bf_hi(v.x), a2 = bf_lo(v.y), a3 = bf_hi(v.y), a4 = bf_lo(v.z), a5 = bf_hi(v.z), a6 = bf_lo(v.w), a7 = bf_hi(v.w);
        const float s = wave_sum(((a0 + a1) + (a2 + a3)) + ((a4 + a5) + (a6 + a7)));
        const float mu = s * (1.f / 512.f);
        const float d0 = a0 - mu, d1 = a1 - mu, d2 = a2 - mu, d3 = a3 - mu, d4 = a4 - mu, d5 = a5 - mu, d6 = a6 - mu, d7 = a7 - mu;
        const float q = wave_sum(((d0 * d0 + d1 * d1) + (d2 * d2 + d3 * d3)) + ((d4 * d4 + d5 * d5) + (d6 * d6 + d7 * d7)));
        if (lane == 0) { stat[2 * t] = mu; stat[2 * t + 1] = rsqrtf(q * (1.f / 512.f) + EPS); } }
    __syncthreads();
    const int wt = w & 3, wc2 = w >> 2;
    const int tt = tid >> 2, cq = tid & 3;
    for (int g = 0; g < 4; ++g) {
        { const float mu = stat[2 * tt], rs = stat[2 * tt + 1];
          const float* lg = P.sg_ln_g + l * 512 + g * 128 + cq * 32; const float* lb = P.sg_ln_b + l * 512 + g * 128 + cq * 32;
#pragma unroll
          for (int i = 0; i < 4; ++i) { const u32x4 v = *(const u32x4*)(Pj + (rowbase + tt) * NIN + C_VS + g * 128 + cq * 32 + i * 8);
              const float a[8] = {bf_lo(v.x), bf_hi(v.x), bf_lo(v.y), bf_hi(v.y), bf_lo(v.z), bf_hi(v.z), bf_lo(v.w), bf_hi(v.w)};
#pragma unroll
              for (int e = 0; e < 8; ++e) { const float o = (a[e] - mu) * rs * lg[i * 8 + e] + lb[i * 8 + e];
                  T[(cq * 32 + i * 8 + e) * 136 + tt] = (bf16_t)(cvt_pk_bf16(o, 0.f) & 0xffffu); } } }
        __syncthreads();
        f32x16 acc[2];
#pragma unroll
        for (int r = 0; r < 16; ++r) { acc[0][r] = 0.f; acc[1][r] = 0.f; }
        for (int ks = 0; ks < 2 * (wt + 1); ++ks) {
            const bf16x8 af = *(const bf16x8*)(sgw + (size_t)(g * 128 + 32 * wt + r32) * 128 + 16 * ks + 8 * hi);
#pragma unroll
            for (int cb = 0; cb < 2; ++cb) { const bf16x8 bfv = *(const LAS bf16x8*)(T + (64 * wc2 + 32 * cb + r32) * 136 + 16 * ks + 8 * hi); acc[cb] = MFMA32(af, bfv, acc[cb]); } }
        const float* bs = P.sg_b + (size_t)l * 512 + g * 128;
#pragma unroll
        for (int cb = 0; cb < 2; ++cb)
#pragma unroll
            for (int r = 0; r < 16; ++r) { const int t = 32 * wt + crow(r, hi); bf16_t* up = Pj + (rowbase + t) * NIN + C_U + g * 128 + 64 * wc2 + 32 * cb + r32;
                const float uv = __uint_as_float((unsigned)(*up) << 16); if (st) *up = (bf16_t)(cvt_pk_bf16(uv * (acc[cb][r] + bs[t]), 0.f) & 0xffffu); }
        __syncthreads();
    }
    for (int g = 0; g < 4; ++g) {
        const int win = 2 << g; const int tpos = ck * 128 + tt; const int cnt = (tpos + 1 < win) ? tpos + 1 : win; const float inv = 1.0f / (float)cnt;
#pragma unroll
        for (int i = 0; i < 4; ++i) { const bf16_t* xp = Pj + (rowbase + tt) * NIN + C_XP + g * 128 + cq * 32 + i * 8;
            float s[8]; float x0[8];
            { const u32x4 v = *(const u32x4*)xp; x0[0] = bf_lo(v.x); x0[1] = bf_hi(v.x); x0[2] = bf_lo(v.y); x0[3] = bf_hi(v.y); x0[4] = bf_lo(v.z); x0[5] = bf_hi(v.z); x0[6] = bf_lo(v.w); x0[7] = bf_hi(v.w); }
#pragma unroll
            for (int e = 0; e < 8; ++e) s[e] = x0[e];
            for (int j = 1; j < cnt; ++j) { const u32x4 v = *(const u32x4*)(xp - (size_t)j * NIN);
                s[0] += bf_lo(v.x); s[1] += bf_hi(v.x); s[2] += bf_lo(v.y); s[3] += bf_hi(v.y); s[4] += bf_lo(v.z); s[5] += bf_hi(v.z); s[6] += bf_lo(v.w); s[7] += bf_hi(v.w); }
            u32x4 o; o.x = cvt_pk_bf16(s[0] * inv - x0[0], s[1] * inv - x0[1]); o.y = cvt_pk_bf16(s[2] * inv - x0[2], s[3] * inv - x0[3]);
            o.z = cvt_pk_bf16(s[4] * inv - x0[4], s[5] * inv - x0[5]); o.w = cvt_pk_bf16(s[6] * inv - x0[6], s[7] * inv - x0[7]);
            *(LAS u32x4*)(T + tt * 136 + cq * 32 + i * 8) = o; }
        __syncthreads();
        f32x16 acc[2];
#pragma unroll
        for (int r = 0; r < 16; ++r) { acc[0][r] = 0.f; acc[1][r] = 0.f; }
#pragma unroll
        for (int ks = 0; ks < 8; ++ks) {
            const bf16x8 af = *(const LAS bf16x8*)(T + (32 * wt + r32) * 136 + 16 * ks + 8 * hi);
#pragma unroll
            for (int cb = 0; cb < 2; ++cb) { const bf16x8 bfv = *(const bf16x8*)(plw + (size_t)(g * 128 + 64 * wc2 + 32 * cb + r32) * 128 + 16 * ks + 8 * hi); acc[cb] = MFMA32(af, bfv, acc[cb]); } }
#pragma unroll
        for (int cb = 0; cb < 2; ++cb) { const float sc = P.pool_scale[l * 512 + g * 128 + 64 * wc2 + 32 * cb + r32];
#pragma unroll
            for (int r = 0; r < 16; ++r) { const int t = 32 * wt + crow(r, hi);
                if (st) Pj[(rowbase + t) * NIN + C_VS + g * 128 + 64 * wc2 + 32 * cb + r32] = (bf16_t)(cvt_pk_bf16(acc[cb][r] * sc, 0.f) & 0xffffu); } }
        __syncthreads();
    }
}
}
using namespace mk;
#ifndef REP_MIX
#define REP_MIX 1
#endif
#ifndef REP_GEMM
#define REP_GEMM 1
#endif
struct Args { Ptrs p; int ph_lo, ph_hi; };
constexpr int N_PHASES = 1 + 8 * NLAYER;

__global__ void __launch_bounds__(512, 2) mega_fwd(Args args) {
    extern __shared__ __attribute__((aligned(16))) unsigned char lds_raw[];
    LAS unsigned char* lds = (LAS unsigned char*)lds_raw;
    cg::grid_group grid = cg::this_grid();
    const Ptrs& P = args.p;
    const int G = gridDim.x, bid = blockIdx.x;
    const int lo = args.ph_lo, hi = args.ph_hi;
    int ph = 0;
#define FRESH const int tid = pg8::fresh_tid(), lane = tid & 63, wave = __builtin_amdgcn_readfirstlane(tid >> 6); const int gw = bid * 8 + wave, NGW = G * 8, gtid = bid * 512 + tid, NGT = G * 512; \
    unsigned char* ws = pg8::fresh_ptr(P.ws); (void)lane; (void)gw; (void)NGW; (void)gtid; (void)NGT; \
    bf16_t* W_IN = (bf16_t*)(ws + WS_WIN); bf16_t* W_BR = (bf16_t*)(ws + WS_WBR); bf16_t* W_OUT = (bf16_t*)(ws + WS_WOUT); bf16_t* W_UP = (bf16_t*)(ws + WS_WUP); bf16_t* W_DN = (bf16_t*)(ws + WS_WDN); \
    bf16_t* Hb = (bf16_t*)(ws + WS_H); bf16_t* Pj = (bf16_t*)(ws + WS_P); bf16_t* ACT = (bf16_t*)(ws + WS_ACT); bf16_t* Yb = (bf16_t*)(ws + WS_Y); \
    (void)W_IN; (void)W_BR; (void)W_OUT; (void)W_UP; (void)W_DN; (void)Hb; (void)Pj; (void)ACT; (void)Yb;
#define RUN(k) (lo <= (k) && (k) < hi)
#define SEAM(k) do { if (lo <= (k) && (k) + 1 < hi) { asm volatile("s_waitcnt vmcnt(0)" ::: "memory"); grid.sync(); \
        if (threadIdx.x == 0) { __builtin_amdgcn_fence(__ATOMIC_ACQUIRE, "agent"); asm volatile("s_waitcnt vmcnt(0)" ::: "memory"); } __syncthreads(); } } while (0)

    if (RUN(ph)) { FRESH
        convert_weights(P, 0, lds, gw, NGW, lane, gtid, NGT);
        for (int m = gw * 4; m < MTOK; m += NGW * 4) norm_rows4(P.x, P.norm_pre_mix, Hb, m, lane);
    }
    SEAM(ph); ++ph;
    for (int l = 0; l < NLAYER; ++l) {
        const float* xin = (l == 0) ? P.x : P.out;
        if (RUN(ph)) { FRESH
            for (int rep = 0; rep < REP_GEMM; ++rep) {
            pg8::Gemm g{Hb, W_IN, MTOK, NIN, DM, DM, DM, 0}; pg8::StaticOrder S; S.init(MTOK, NIN, G, bid);
            pg8::EpiProj E{Pj, NIN, QSCALE};
            pg8::gemm_phase<pg8::EpiProj, pg8::StaticOrder, true, true>(lds, g, S, E); }
        }
        SEAM(ph); ++ph;
        if (RUN(ph)) { FRESH
            for (int rep = 0; rep < REP_MIX; ++rep) { int rr = rep; asm volatile("" : "+s"(rr)); const bool st = (rr == REP_MIX - 1);
            for (int it = bid; it < 1024 + 256; it += G) {
                if (it < 1024) { const int bh = it & 63, qb = 15 - (it >> 6); attn_unit(lds, Pj, bh >> 3, bh & 7, qb, st); }
                else { const int u = it - 1024; sgp_unit(lds, P, l, Pj, u >> 5, u & 31, st); }
            } }
        }
        SEAM(ph); ++ph;
        if (RUN(ph)) { FRESH
            for (int rep = 0; rep < REP_GEMM; ++rep) {
            pg8::StaticOrder S; S.init(MTOK, DM, G, bid);
            { pg8::Gemm g{Pj + C_Q, W_BR, MTOK, DM, 512, NIN, 512, 0}; pg8::EpiMerge<1> E{Hb, DM, Pj + C_G, NIN}; pg8::gemm_phase<pg8::EpiMerge<1>, pg8::StaticOrder, true, true>(lds, g, S, E); }
            { pg8::Gemm g{Pj + C_U, W_BR + (size_t)DM * 512, MTOK, DM, 512, NIN, 512, 0}; pg8::EpiMerge<0> E{Hb, DM, Pj + C_G + DM, NIN}; pg8::gemm_phase<pg8::EpiMerge<0>, pg8::StaticOrder, true, true>(lds, g, S, E); }
            { pg8::Gemm g{Pj + C_VS, W_BR + (size_t)2 * DM * 512, MTOK, DM, 512, NIN, 512, 0}; pg8::EpiMerge<0> E{Hb, DM, Pj + C_G + 2 * DM, NIN}; pg8::gemm_phase<pg8::EpiMerge<0>, pg8::StaticOrder, true, true>(lds, g, S, E); } }
        }
        SEAM(ph); ++ph;
        if (RUN(ph)) { FRESH
            for (int rep = 0; rep < REP_GEMM; ++rep) {
            pg8::Gemm g{Hb, W_OUT, MTOK, DM, DM, DM, DM, 0}; pg8::StaticOrder S; S.init(MTOK, DM, G, bid);
            pg8::EpiPlain E{Yb, DM};
            pg8::gemm_phase<pg8::EpiPlain, pg8::StaticOrder, true, true>(lds, g, S, E); }
        }
        SEAM(ph); ++ph;
        if (RUN(ph)) { FRESH
            for (int m = gw * 4; m < MTOK; m += NGW * 4) resid_rows4(xin, Yb, P.norm_post_mix + l * DM, P.out, P.norm_pre_ffn + l * DM, Hb, m, lane);
        }
        SEAM(ph); ++ph;
        if (RUN(ph)) { FRESH
            pg8::Gemm g{Hb, W_UP, 136 * 256, NUP, DM, DM, DM, 1}; pg8::StaticOrder S; S.init(136 * 256, NUP, G, bid);
            pg8::EpiGeglu E{ACT, P.conv_w + (size_t)l * 3 * NUP, P.conv_b + (size_t)l * NUP, (PG8_LAS pg8::f32x4*)(lds + 131072), NUP, DFF};
            pg8::gemm_phase<pg8::EpiGeglu, pg8::StaticOrder, true, true>(lds, g, S, E);
        }
        SEAM(ph); ++ph;
        if (RUN(ph)) { FRESH
            pg8::Gemm g{ACT, W_DN, MTOK, DM, DFF, DFF, DFF, 0}; pg8::StaticOrder S; S.init(MTOK, DM, G, bid); pg8::EpiPlain E{Yb, DM};
            pg8::gemm_phase<pg8::EpiPlain, pg8::StaticOrder, true, true>(lds, g, S, E);
        }
        SEAM(ph); ++ph;
        if (RUN(ph)) { FRESH
            const bool more = (l + 1 < NLAYER);
            if (more) convert_weights(P, l + 1, lds, gw, NGW, lane, gtid, NGT);
            for (int m = gw * 4; m < MTOK; m += NGW * 4) resid_rows4(P.out, Yb, P.norm_post_ffn + l * DM, P.out, more ? P.norm_pre_mix + (l + 1) * DM : nullptr, Hb, m, lane);
        }
        SEAM(ph); ++ph;
    }
#undef RUN
#undef FRESH
#undef SEAM
}

#ifndef MK_MULTI_LAUNCH
#define MK_MULTI_LAUNCH 0
#endif
extern "C" void kernel_launch(void* const* d_in, const int* in_sizes, int n_in, void* d_out, int out_size, void* d_ws, size_t ws_size, hipStream_t stream) {
    static int grid = 0;
    if (grid == 0) {
        if (n_in != 18 || out_size != MTOK * DM || ws_size < WS_END) { fprintf(stderr, "kernel_launch: unexpected shapes (n_in %d out %d ws %zu)\n", n_in, out_size, ws_size); grid = -1; return; }
        int dev = 0, cus = 0, per_cu = 0;
        (void)hipGetDevice(&dev); (void)hipDeviceGetAttribute(&cus, hipDeviceAttributeMultiprocessorCount, dev);
        if (hipFuncSetAttribute((const void*)mega_fwd, hipFuncAttributeMaxDynamicSharedMemorySize, LDS_BYTES) != hipSuccess) { fprintf(stderr, "kernel_launch: hipFuncSetAttribute failed\n"); grid = -1; return; }
        if (hipOccupancyMaxActiveBlocksPerMultiprocessor(&per_cu, (const void*)mega_fwd, 512, LDS_BYTES) != hipSuccess || per_cu < 1) { fprintf(stderr, "kernel_launch: occupancy query gave %d\n", per_cu); per_cu = 1; }
        (void)hipGetLastError();
        grid = cus * per_cu;
        fprintf(stderr, "kernel_launch: grid %d (cus %d x %d)\n", grid, cus, per_cu);
    }
    if (grid < 0) return;
    Args a{};
    const float** pp = (const float**)&a.p;
    for (int i = 0; i < 18; ++i) pp[i] = (const float*)d_in[i];
    a.p.out = (float*)d_out; a.p.ws = (unsigned char*)d_ws;
#if MK_MULTI_LAUNCH
    for (int k = 0; k < N_PHASES; ++k) { a.ph_lo = k; a.ph_hi = k + 1; hipLaunchKernelGGL(mega_fwd, dim3(grid), dim3(512), LDS_BYTES, stream, a); }
#else
    a.ph_lo = 0; a.ph_hi = N_PHASES;
    void* kargs[] = {&a};
    hipError_t e = hipLaunchCooperativeKernel((const void*)mega_fwd, dim3(grid), dim3(512), kargs, LDS_BYTES, stream);
    if (e != hipSuccess) fprintf(stderr, "kernel_launch: cooperative launch failed: %s (grid %d)\n", hipGetErrorString(e), grid);
#endif
}
```
